# Optimizing an MI355X kernel written in HIP

```python
import jax, jax.numpy as jnp
from jax import lax
import numpy as np

D_MODEL = 1024
BATCH = 8
SEQ = 2048
DEPTH = 2
DEC_BATCH = 128
DEC_SEQ = 8
PAST_LEN = 16384
PAGE_SIZE = 128

HEAD_DIM = 64
D_A = D_MODEL // 2
N_HEADS_A = D_A // HEAD_DIM
LORA_W = 64
LORA_A = 64
LORA_G = 128
D_SHIFT = 3 * D_A + LORA_W + LORA_A + LORA_G
D_POOL = D_MODEL - D_A
POOL_WINDOWS = (2, 4, 8, 16)
N_POOL_GROUPS = len(POOL_WINDOWS)
POOL_GD = D_POOL // N_POOL_GROUPS
POOL_BUF = max(POOL_WINDOWS) - 1
D_IN = D_SHIFT + D_POOL + 2 * D_MODEL
D_FF = 4 * D_MODEL
RMS_EPS = 1e-6
GN_EPS = HEAD_DIM * 1e-5
L2_EPS = 1e-12

kernel_name = 'rwkv7_multiscale_pool_gated_hybrid_step'


def _rmsnorm(x, g):
    xf = x.astype(jnp.float32)
    y = xf * lax.rsqrt(jnp.mean(xf * xf, axis=-1, keepdims=True) + RMS_EPS)
    return (y * g.astype(jnp.float32)).astype(x.dtype)


def _wkv7_scan(r, w, k, v, a, b, s0):
    def step(s, inp):
        rt, wt, kt, vt, at, bt = inp
        sa = jnp.einsum('bhij,bhj->bhi', s, at)
        s = s * wt[:, :, None, :] + sa[..., None] * bt[:, :, None, :] + vt[..., None] * kt[:, :, None, :]
        y = jnp.einsum('bhij,bhj->bhi', s, rt)
        return s, y
    xs = (jnp.moveaxis(r, 1, 0), jnp.moveaxis(w, 1, 0), jnp.moveaxis(k, 1, 0),
          jnp.moveaxis(v, 1, 0), jnp.moveaxis(a, 1, 0), jnp.moveaxis(b, 1, 0))
    s_final, ys = lax.scan(step, s0, xs)
    return jnp.moveaxis(ys, 0, 1), s_final


def _mixer(h, shift_prev, pool_prev, wkv_prev, pos0,
           w_in, mu_shift, decay0, w_decay2, a0, w_a2, w_g2, k_k, k_a, r_k,
           ln_x_g, ln_x_b, w_a_up, w_pool, pool_scale, w_b_up, w_o):
    f32 = jnp.float32
    bsz, t_len, _ = h.shape
    z = h @ w_in
    z_rw = z[..., :D_SHIFT]
    u = z[..., D_SHIFT:D_SHIFT + D_POOL]
    gate_a = jax.nn.sigmoid(z[..., D_SHIFT + D_POOL:D_SHIFT + D_POOL + D_MODEL].astype(f32))
    gate_b = jax.nn.sigmoid(z[..., D_SHIFT + D_POOL + D_MODEL:].astype(f32))

    z_prev = jnp.concatenate([shift_prev[:, None, :].astype(z.dtype), z_rw[:, :-1]], axis=1)
    zs = (z_rw + (z_prev - z_rw) * mu_shift).astype(f32)
    o1, o2, o3 = D_A, 2 * D_A, 3 * D_A
    o4 = o3 + LORA_W
    o5 = o4 + LORA_A
    r = zs[..., :o1]
    k = zs[..., o1:o2]
    v = zs[..., o2:o3]
    lw = zs[..., o3:o4]
    la = zs[..., o4:o5]
    lg = zs[..., o5:]
    w_log = -jax.nn.softplus(-(decay0.astype(f32) + jnp.tanh(lw) @ w_decay2.astype(f32))) - 0.5
    decay = jnp.exp(-jnp.exp(w_log))
    a_in = jax.nn.sigmoid(a0.astype(f32) + la @ w_a2.astype(f32))
    g = jax.nn.sigmoid(lg) @ w_g2.astype(f32)
    hs = (bsz, t_len, N_HEADS_A, HEAD_DIM)
    kk = (k * k_k.astype(f32)).reshape(hs)
    kk = kk / jnp.maximum(jnp.sqrt(jnp.sum(kk * kk, axis=-1, keepdims=True)), L2_EPS)
    k = k * (1.0 + (a_in - 1.0) * k_a.astype(f32))
    rh = r.reshape(hs)
    kh = k.reshape(hs)
    vh = v.reshape(hs)
    ah = a_in.reshape(hs)
    y, wkv_new = _wkv7_scan(rh, decay.reshape(hs), kh, vh, -kk, kk * ah, wkv_prev.astype(f32))
    mu = jnp.mean(y, axis=-1, keepdims=True)
    var = jnp.mean(jnp.square(y - mu), axis=-1, keepdims=True)
    yn = ((y - mu) * lax.rsqrt(var + GN_EPS)).reshape(bsz, t_len, D_A)
    yn = yn * ln_x_g.astype(f32) + ln_x_b.astype(f32)
    bonus = (jnp.sum(rh * kh * r_k.astype(f32), axis=-1, keepdims=True) * vh).reshape(bsz, t_len, D_A)
    a_out = (((yn + bonus) * g).astype(h.dtype)) @ w_a_up

    full = jnp.concatenate([pool_prev.astype(u.dtype), u], axis=1)
    csum = lax.cumsum(full.astype(f32), axis=1)
    csum = jnp.concatenate([jnp.zeros_like(csum[:, :1]), csum], axis=1)
    pos = pos0 + jnp.arange(t_len)
    means = []
    for gi, win in enumerate(POOL_WINDOWS):
        sl = slice(gi * POOL_GD, (gi + 1) * POOL_GD)
        win_sum = (csum[:, POOL_BUF + 1:POOL_BUF + 1 + t_len, sl]
                   - csum[:, POOL_BUF + 1 - win:POOL_BUF + 1 - win + t_len, sl])
        cnt = jnp.minimum(pos + 1, win).astype(f32)[None, :, None]
        means.append(win_sum / cnt)
    p = (jnp.concatenate(means, axis=-1) - u.astype(f32)).astype(h.dtype)
    p = p.reshape(bsz, t_len, N_POOL_GROUPS, POOL_GD)
    p = jnp.einsum('btgc,gcd->btgd', p, w_pool).reshape(bsz, t_len, D_POOL) * pool_scale
    b_out = p @ w_b_up

    merged = (gate_a * a_out + gate_b * b_out).astype(h.dtype)
    out = merged @ w_o
    return out, z_rw[:, -1], full[:, -POOL_BUF:], wkv_new.astype(wkv_prev.dtype)


def _trunk(x, shift0, pool0, wkv0, pos0, norm1_g, norm2_g, final_norm_g, mixer_w, w_ff1, w_ff2):
    shifts, pools, wkvs = [], [], []
    for l in range(DEPTH):
        h = _rmsnorm(x, norm1_g[l])
        m, s_sh, s_pl, s_wk = _mixer(h, shift0[l], pool0[l], wkv0[l], pos0,
                                     *[wt[l] for wt in mixer_w])
        x = x + m
        h = _rmsnorm(x, norm2_g[l])
        x = x + jnp.square(jax.nn.relu(h @ w_ff1[l])) @ w_ff2[l]
        shifts.append(s_sh)
        pools.append(s_pl)
        wkvs.append(s_wk)
    return _rmsnorm(x, final_norm_g), jnp.stack(shifts), jnp.stack(pools), jnp.stack(wkvs)


def setup_inputs(seed: int = 0) -> dict:
    key = jax.random.key(seed)
    ks = jax.random.split(key, 32)

    def nrm(k, shape, scale):
        return jax.random.normal(k, shape, jnp.float32) * scale

    L = DEPTH
    return {
        'x_prompt': nrm(ks[0], (BATCH, SEQ, D_MODEL), 1.0),
        'x_sample': nrm(ks[1], (DEC_BATCH, DEC_SEQ, D_MODEL), 1.0),
        'state_shift': nrm(ks[2], (L, DEC_BATCH, D_SHIFT), 1.0),
        'state_pool': nrm(ks[3], (L, DEC_BATCH, POOL_BUF, D_POOL), 1.0),
        'state_wkv': nrm(ks[4], (L, DEC_BATCH, N_HEADS_A, HEAD_DIM, HEAD_DIM), 0.3),
        'norm1_g': 1.0 + nrm(ks[5], (L, D_MODEL), 0.05),
        'w_in': nrm(ks[6], (L, D_MODEL, D_IN), D_MODEL ** -0.5),
        'mu_shift': jax.random.uniform(ks[7], (L, D_SHIFT), jnp.float32, 0.1, 0.9),
        'decay0': -1.0 + nrm(ks[8], (L, D_A), 0.5),
        'w_decay2': nrm(ks[9], (L, LORA_W, D_A), 0.1 * LORA_W ** -0.5),
        'a0': nrm(ks[10], (L, D_A), 0.1),
        'w_a2': nrm(ks[11], (L, LORA_A, D_A), 0.5 * LORA_A ** -0.5),
        'w_g2': nrm(ks[12], (L, LORA_G, D_A), LORA_G ** -0.5),
        'k_k': 0.85 + nrm(ks[13], (L, D_A), 0.05),
        'k_a': 1.0 + nrm(ks[14], (L, D_A), 0.05),
        'r_k': nrm(ks[15], (L, N_HEADS_A, HEAD_DIM), 0.1),
        'ln_x_g': 1.0 + nrm(ks[16], (L, D_A), 0.05),
        'ln_x_b': nrm(ks[17], (L, D_A), 0.02),
        'w_a_up': nrm(ks[18], (L, D_A, D_MODEL), D_A ** -0.5),
        'w_pool': nrm(ks[19], (L, N_POOL_GROUPS, POOL_GD, POOL_GD), POOL_GD ** -0.5),
        'pool_scale': 1.0 + nrm(ks[20], (L, D_POOL), 0.1),
        'w_b_up': nrm(ks[21], (L, D_POOL, D_MODEL), D_POOL ** -0.5),
        'w_o': nrm(ks[22], (L, D_MODEL, D_MODEL), D_MODEL ** -0.5),
        'norm2_g': 1.0 + nrm(ks[23], (L, D_MODEL), 0.05),
        'w_ff1': nrm(ks[24], (L, D_MODEL, D_FF), D_MODEL ** -0.5),
        'w_ff2': nrm(ks[25], (L, D_FF, D_MODEL), D_FF ** -0.5),
        'final_norm_g': 1.0 + nrm(ks[26], (D_MODEL,), 0.05),
    }


def reference(x_prompt, x_sample, state_shift, state_pool, state_wkv,
              norm1_g, w_in, mu_shift, decay0, w_decay2, a0, w_a2, w_g2, k_k, k_a, r_k,
              ln_x_g, ln_x_b, w_a_up, w_pool, pool_scale, w_b_up, w_o,
              norm2_g, w_ff1, w_ff2, final_norm_g):
    mixer_w = (w_in, mu_shift, decay0, w_decay2, a0, w_a2, w_g2, k_k, k_a, r_k,
               ln_x_g, ln_x_b, w_a_up, w_pool, pool_scale, w_b_up, w_o)
    bsz = x_prompt.shape[0]
    shift_zero = jnp.zeros((DEPTH, bsz, D_SHIFT), state_shift.dtype)
    pool_zero = jnp.zeros((DEPTH, bsz, POOL_BUF, D_POOL), state_pool.dtype)
    wkv_zero = jnp.zeros((DEPTH, bsz, N_HEADS_A, HEAD_DIM, HEAD_DIM), state_wkv.dtype)
    y_prompt, p_shift, p_pool, p_wkv = _trunk(
        x_prompt, shift_zero, pool_zero, wkv_zero, 0,
        norm1_g, norm2_g, final_norm_g, mixer_w, w_ff1, w_ff2)
    y_sample, s_shift, s_pool, s_wkv = _trunk(
        x_sample, state_shift, state_pool, state_wkv, PAST_LEN,
        norm1_g, norm2_g, final_norm_g, mixer_w, w_ff1, w_ff2)
    return (y_prompt, y_sample, p_shift, p_pool, p_wkv, s_shift, s_pool, s_wkv)
```

```cpp
#include <hip/hip_runtime.h>
#include <hip/hip_cooperative_groups.h>
#include <cstdio>
#include <cstddef>
namespace cg = cooperative_groups;

#ifndef MULTI_LAUNCH
#define MULTI_LAUNCH 0
#endif

#define LAS __attribute__((address_space(3)))
typedef unsigned short bf16_t;
typedef short bf16x8 __attribute__((ext_vector_type(8)));
typedef float f32x4 __attribute__((ext_vector_type(4)));
typedef float f32x2 __attribute__((ext_vector_type(2)));
typedef unsigned u32x4 __attribute__((ext_vector_type(4)));
typedef unsigned u32x2 __attribute__((ext_vector_type(2)));

constexpr int T_ALL = 17408, T_P = 16384, SEQ = 2048, DSEQ = 8, NB = 8, NSB = 128;
constexpr int DM = 1024, DIN = 4352, DSH = 1792, DA = 512, DFF = 4096;
constexpr int O_LORA = 1536, O_U = 1792, O_GA = 2304, O_GB = 3328;
constexpr int LDS_BYTES = 131072 + 16;

constexpr size_t OUT_Y = 0;
constexpr size_t OUT_PSHIFT = 17825792;
constexpr size_t OUT_PPOOL = 17854464;
constexpr size_t OUT_PWKV = 17977344;
constexpr size_t OUT_SSHIFT = 18501632;
constexpr size_t OUT_SPOOL = 18960384;
constexpr size_t OUT_SWKV = 20926464;

struct Params {
    const float *x_prompt, *x_sample, *state_shift, *state_pool, *state_wkv;
    const float *norm1_g, *w_in, *mu_shift, *decay0, *w_decay2, *a0, *w_a2, *w_g2, *k_k, *k_a, *r_k, *ln_x_g, *ln_x_b;
    const float *w_a_up, *w_pool, *pool_scale, *w_b_up, *w_o, *norm2_g, *w_ff1, *w_ff2, *final_g;
    float* out;
    bf16_t *WinT, *LoraT, *PoolT, *BupT, *AupT, *WoT, *Wff1T, *Wff2T;
    bf16_t *xb;
    float* ssq;
    bf16_t* z;
    bf16_t* L;
    bf16_t* sc_a;
    bf16_t* sc_g;
    float* rk;
    unsigned* bar;
    int phase_type, phase_layer;
};

__device__ __forceinline__ float bf2f(bf16_t b) { return __uint_as_float(((unsigned)b) << 16); }
__device__ __forceinline__ float bflo(unsigned w) { return __uint_as_float(w << 16); }
__device__ __forceinline__ float bfhi(unsigned w) { return __uint_as_float(w & 0xffff0000u); }
__device__ __forceinline__ unsigned pk2(float lo, float hi) { unsigned r; asm volatile("v_cvt_pk_bf16_f32 %0, %1, %2" : "=v"(r) : "v"(lo), "v"(hi)); return r; }
__device__ __forceinline__ bf16_t f2bf(float f) { return (bf16_t)(pk2(f, 0.f) & 0xffffu); }
__device__ __forceinline__ float sigmoidf_(float x) { return 1.0f / (1.0f + __expf(-x)); }
__device__ __forceinline__ float tanhf_(float x) { return 1.0f - 2.0f / (__expf(2.0f * x) + 1.0f); }

template <int OFF> __device__ __forceinline__ void* karg_ptr() {
    unsigned long long r;
    asm volatile("s_load_dwordx2 %0, %1, %2\n\ts_waitcnt lgkmcnt(0)" : "=s"(r) : "s"(__builtin_amdgcn_kernarg_segment_ptr()), "n"(OFF) : "memory");
    return (void*)(__attribute__((address_space(1))) void*)r;
}
template <int OFF> __device__ __forceinline__ int karg_int() {
    int r;
    asm volatile("s_load_dword %0, %1, %2\n\ts_waitcnt lgkmcnt(0)" : "=s"(r) : "s"(__builtin_amdgcn_kernarg_segment_ptr()), "n"(OFF) : "memory");
    return r;
}
#define KP(f) ((decltype(Params::f))karg_ptr<(int)offsetof(Params, f)>())
#define KI(f) (karg_int<(int)offsetof(Params, f)>())

template <int CTRL> __device__ __forceinline__ float dpp_f(float x) {
    return __builtin_bit_cast(float, __builtin_amdgcn_update_dpp(0, __builtin_bit_cast(int, x), CTRL, 0xf, 0xf, false));
}
__device__ __forceinline__ float allsum16(float x) {
    x += dpp_f<0xB1>(x);
    x += dpp_f<0x4E>(x);
    x += dpp_f<0x141>(x);
    x += dpp_f<0x140>(x);
    return x;
}

namespace pg8 {
constexpr int BM = 256, BK = 64, HALF = 128, HTB = HALF * BK * 2, STAGE_BYTES = 8 * HTB, NXCD = 8, WGM = 8;
__host__ __device__ __forceinline__ int lds_byte(int r, int c) { const int st = (r >> 4) * 2 + (c >> 5), rr = r & 15, cc = c & 31, ob = rr * 64 + cc * 2; return st * 1024 + (ob ^ (((ob >> 9) & 1) << 5)); }
__host__ __device__ __forceinline__ void stage_rc(int b, int& R, int& C) { const int st = b / 1024, sb = b % 1024, swz = sb ^ (((sb >> 9) & 1) << 5); R = (st >> 1) * 16 + swz / 64; C = (st & 1) * 32 + (swz % 64) / 2; }
__host__ __device__ __forceinline__ int perm32(int rho) { const int n = rho >> 4, i = rho & 15; return 8 * (i >> 2) + 4 * n + (i & 3); }

struct Unit { int pm, pn; };
struct Gemm { const bf16_t* A; const bf16_t* Bt; int M, N, K, lda, ldb; };

struct StaticOrder {
    int nM, nN, nwg, G, c;
    __device__ void init(int M, int N, int G_, int c_) { nM = M / BM; nN = N / BM; nwg = nM * nN; G = G_; c = c_; }
    __device__ bool next(int i, Unit& u) const {
        const long L = (long)i * G + c; if (L >= nwg) return false;
        int wgid = (int)L; { const int q = nwg / NXCD, r = nwg % NXCD, xcd = wgid % NXCD, off = wgid / NXCD; wgid = (xcd < r ? xcd * (q + 1) : r * (q + 1) + (xcd - r) * q) + off; }
        const int nig = WGM * nN, gid = wgid / nig, fm = gid * WGM, gsz = (nM - fm) < WGM ? (nM - fm) : WGM;
        u.pm = fm + ((wgid % nig) % gsz); u.pn = (wgid % nig) / gsz; return true;
    }
};

template <class Epi>
__device__ __forceinline__ void gemm_phase(LAS unsigned char* lds, const Gemm g, const StaticOrder& S, const Epi& E, const unsigned* ready = nullptr, unsigned need = 0u, int npan = 0) {
    int tid_ = threadIdx.x; asm volatile("" : "+v"(tid_));
    const int tid = tid_, wid = __builtin_amdgcn_readfirstlane(tid >> 6), lane = tid & 63, wr = wid >> 2, wc = wid & 3, fr = lane & 15, fq = lane >> 4;
    const int K = g.K, nt = K / BK, lda = g.lda, ldb = g.ldb;
    unsigned voffA[2], voffB[2];
#pragma unroll
    for (int i = 0; i < 2; ++i) { int R, C; stage_rc(tid * 16 + i * 8192, R, C); const int Rb = Epi::PERM ? ((R & ~31) + perm32(R & 31)) : R;
        voffA[i] = (unsigned)(R * lda + C) * 2u; voffB[i] = (unsigned)(Rb * ldb + C) * 2u; }
    const size_t kstep = (size_t)(BK * 2);
    const size_t hA = (size_t)HALF * lda * 2, hB = (size_t)HALF * ldb * 2;
    const size_t tA = 2 * hA, tB = 2 * hB;
    const unsigned ldsw = (unsigned)wid * 1024u;
    const int aoff = lds_byte(wr * 64 + fr, fq * 8), boff = lds_byte(wc * 32 + fr, fq * 8);
#define PG8_SA(b, h) (((b) * 2 + (h)) * HTB)
#define PG8_SB(b, h) ((4 + (b) * 2 + (h)) * HTB)
#define PG8_STAGE(bufoff, gbase, voff) do { _Pragma("unroll") for (int _i = 0; _i < 2; ++_i) \
        __builtin_amdgcn_global_load_lds((const unsigned*)((const char*)(gbase) + (voff)[_i]), (LAS unsigned*)(lds + (bufoff) + ldsw + _i * 8192), 16, 0, 0); } while (0)
#define PG8_LDA(dst, b, h) do { _Pragma("unroll") for (int m = 0; m < 4; ++m) _Pragma("unroll") for (int k = 0; k < 2; ++k) dst[m][k] = *(const LAS bf16x8*)(lds + PG8_SA(b, h) + aoff + m * 2048 + k * 1024); } while (0)
#define PG8_LDB(dst, b, h) do { _Pragma("unroll") for (int n = 0; n < 2; ++n) _Pragma("unroll") for (int k = 0; k < 2; ++k) dst[n][k] = *(const LAS bf16x8*)(lds + PG8_SB(b, h) + boff + n * 2048 + k * 1024); } while (0)
#define PG8_MMA(ai, bj, At, Bt) do { __builtin_amdgcn_s_setprio(1); _Pragma("unroll") for (int m = 0; m < 4; ++m) _Pragma("unroll") for (int n = 0; n < 2; ++n) _Pragma("unroll") for (int k = 0; k < 2; ++k) \
        acc[ai][bj][m][n] = __builtin_amdgcn_mfma_f32_16x16x32_bf16(Bt[n][k], At[m][k], acc[ai][bj][m][n], 0, 0, 0); __builtin_amdgcn_s_setprio(0); } while (0)
#define PG8_WAIT_V(n) asm volatile("s_waitcnt vmcnt(" #n ")" ::: "memory")
#define PG8_WAIT_L(n) asm volatile("s_waitcnt lgkmcnt(" #n ")" ::: "memory")
#define PG8_BAR __builtin_amdgcn_s_barrier()
#define PG8_SCHED __builtin_amdgcn_sched_barrier(0)
    Unit cur, nxt; int ui = 0;
    if (!S.next(0, cur)) return;
#define PG8_A_READY(u_) do { if (ready) { if (tid < 64) { unsigned polls_ = 0; \
            if (npan > 0) { while (!__all(tid >= npan || __hip_atomic_load(ready + 64 * (tid < npan ? tid : 0), __ATOMIC_RELAXED, __HIP_MEMORY_SCOPE_AGENT) >= need)) { __builtin_amdgcn_s_sleep(2); if (++polls_ > (1u << 21)) break; } } \
            else while ((unsigned)__builtin_amdgcn_readfirstlane(__hip_atomic_load(ready + 64 * (u_).pm, __ATOMIC_RELAXED, __HIP_MEMORY_SCOPE_AGENT)) < need) { __builtin_amdgcn_s_sleep(2); if (++polls_ > (1u << 21)) break; } \
            __builtin_amdgcn_fence(__ATOMIC_ACQUIRE, "agent"); asm volatile("s_waitcnt vmcnt(0)" ::: "memory"); } \
        asm volatile("" ::: "memory"); __builtin_amdgcn_s_barrier(); asm volatile("" ::: "memory"); } } while (0)
    f32x4 acc[2][2][4][2];
#pragma unroll
    for (int a = 0; a < 2; ++a)
#pragma unroll
        for (int b = 0; b < 2; ++b)
#pragma unroll
            for (int m = 0; m < 4; ++m)
#pragma unroll
                for (int n = 0; n < 2; ++n) acc[a][b][m][n] = (f32x4){0.f, 0.f, 0.f, 0.f};
    bf16x8 At[4][2], B0[2][2], B1[2][2];
    const char* cA = (const char*)g.A + (size_t)cur.pm * tA; const char* cB = (const char*)g.Bt + (size_t)cur.pn * tB;
    PG8_A_READY(cur);
    PG8_STAGE(PG8_SB(0, 0), cB, voffB); PG8_STAGE(PG8_SA(0, 0), cA, voffA); PG8_STAGE(PG8_SB(0, 1), cB + hB, voffB); PG8_STAGE(PG8_SA(0, 1), cA + hA, voffA);
    if (wr == 1) PG8_BAR;
    PG8_WAIT_V(4); PG8_BAR;
    PG8_STAGE(PG8_SB(1, 0), cB + kstep, voffB); PG8_STAGE(PG8_SA(1, 0), cA + kstep, voffA); PG8_STAGE(PG8_SB(1, 1), cB + hB + kstep, voffB);
    PG8_WAIT_V(6); PG8_BAR;
    for (;;) {
        const bool has_next = S.next(ui + 1, nxt);
        const char* nA = has_next ? (const char*)g.A + (size_t)nxt.pm * tA : cA; const char* nB = has_next ? (const char*)g.Bt + (size_t)nxt.pn * tB : cB;
#pragma unroll 1
        for (int t = 0; t < nt; t += 2) {
            const bool last = (t == nt - 2);
            const char* a1 = cA + (size_t)(t + 1) * kstep;
            const char* a2 = last ? nA : cA + (size_t)(t + 2) * kstep; const char* b2 = last ? nB : cB + (size_t)(t + 2) * kstep;
            const char* a3 = a2 + kstep; const char* b3 = b2 + kstep;
            if (last && has_next) PG8_A_READY(nxt);
            PG8_LDB(B0, 0, 0); PG8_SCHED; PG8_LDA(At, 0, 0); PG8_STAGE(PG8_SA(1, 1), a1 + hA, voffA);
            PG8_WAIT_L(8); PG8_BAR; PG8_WAIT_L(0); PG8_MMA(0, 0, At, B0); PG8_BAR; PG8_SCHED;
            PG8_LDB(B1, 0, 1); PG8_STAGE(PG8_SB(0, 0), b2, voffB);
            PG8_BAR; PG8_WAIT_L(0); PG8_MMA(0, 1, At, B1); PG8_BAR;
            PG8_LDA(At, 0, 1); PG8_STAGE(PG8_SA(0, 0), a2, voffA);
            PG8_BAR; PG8_WAIT_L(0); PG8_MMA(1, 0, At, B0); PG8_BAR; PG8_SCHED;
            PG8_STAGE(PG8_SB(0, 1), b2 + hB, voffB);
            PG8_WAIT_V(6); PG8_BAR; PG8_MMA(1, 1, At, B1); PG8_BAR;
            PG8_LDB(B0, 1, 0); PG8_SCHED; PG8_LDA(At, 1, 0); PG8_STAGE(PG8_SA(0, 1), a2 + hA, voffA);
            PG8_WAIT_L(8); PG8_BAR; PG8_WAIT_L(0); PG8_MMA(0, 0, At, B0); PG8_BAR; PG8_SCHED;
            PG8_LDB(B1, 1, 1); PG8_STAGE(PG8_SB(1, 0), b3, voffB);
            PG8_BAR; PG8_WAIT_L(0); PG8_MMA(0, 1, At, B1); PG8_BAR;
            PG8_LDA(At, 1, 1); PG8_STAGE(PG8_SA(1, 0), a3, voffA);
            PG8_BAR; PG8_WAIT_L(0); PG8_MMA(1, 0, At, B0); PG8_BAR; PG8_SCHED;
            PG8_STAGE(PG8_SB(1, 1), b3 + hB, voffB);
            PG8_WAIT_V(6); PG8_BAR; PG8_MMA(1, 1, At, B1); PG8_BAR;
        }
        E(acc, cur, wr, wc, fr, fq);
        if (!has_next) break;
#pragma unroll
        for (int a = 0; a < 2; ++a)
#pragma unroll
            for (int b = 0; b < 2; ++b)
#pragma unroll
                for (int m = 0; m < 4; ++m)
#pragma unroll
                    for (int n = 0; n < 2; ++n) acc[a][b][m][n] = (f32x4){0.f, 0.f, 0.f, 0.f};
        cur = nxt; cA = nA; cB = nB; ++ui;
    }
    PG8_WAIT_V(0);
    if (wr == 0) PG8_BAR;
    PG8_BAR;
#undef PG8_A_READY
#undef PG8_SA
#undef PG8_SB
#undef PG8_STAGE
#undef PG8_LDA
#undef PG8_LDB
#undef PG8_MMA
#undef PG8_WAIT_V
#undef PG8_WAIT_L
#undef PG8_BAR
#undef PG8_SCHED
}
}
using pg8::Unit;

__device__ __forceinline__ float row_rstd(const float* ssq, int row) {
    const f32x4* p = (const f32x4*)(ssq + (size_t)row * 16);
    const f32x4 a = p[0], b = p[1], c = p[2], d = p[3];
    const float s = ((a[0] + a[1]) + (a[2] + a[3])) + ((b[0] + b[1]) + (b[2] + b[3])) + ((c[0] + c[1]) + (c[2] + c[3])) + ((d[0] + d[1]) + (d[2] + d[3]));
    return rsqrtf(s * (1.0f / 1024.0f) + 1e-6f);
}
__device__ __forceinline__ u32x4 pack8(const f32x4 v0, const f32x4 v1) { u32x4 w; w.x = pk2(v0[0], v0[1]); w.y = pk2(v0[2], v0[3]); w.z = pk2(v1[0], v1[1]); w.w = pk2(v1[2], v1[3]); return w; }
__device__ __forceinline__ void unpack8(const u32x4 w, f32x4& v0, f32x4& v1) { v0 = (f32x4){bflo(w.x), bfhi(w.x), bflo(w.y), bfhi(w.y)}; v1 = (f32x4){bflo(w.z), bfhi(w.z), bflo(w.w), bfhi(w.w)}; }

template <int ACT> struct EpiNormBf16 {
    static constexpr bool PERM = true;
    bf16_t* O; int ldc; const float* ssq;
    __device__ __forceinline__ void operator()(const f32x4 (&acc)[2][2][4][2], const Unit& u, int wr, int wc, int fr, int fq) const {
        const int row0 = u.pm * 256 + wr * 64 + fr, col0 = u.pn * 256 + wc * 32 + 8 * fq;
#pragma unroll
        for (int ai = 0; ai < 2; ++ai)
#pragma unroll
            for (int m = 0; m < 4; ++m) {
                const int row = row0 + ai * 128 + m * 16; const float rs = row_rstd(ssq, row);
                bf16_t* rowp = O + (size_t)row * ldc + col0;
#pragma unroll
                for (int bj = 0; bj < 2; ++bj) { f32x4 v0 = acc[ai][bj][m][0] * rs, v1 = acc[ai][bj][m][1] * rs;
                    if (ACT == 1) {
#pragma unroll
                        for (int j = 0; j < 4; ++j) { const float a = fmaxf(v0[j], 0.f), b = fmaxf(v1[j], 0.f); v0[j] = a * a; v1[j] = b * b; } }
                    *(u32x4*)(rowp + bj * 128) = pack8(v0, v1); }
            }
    }
};
struct EpiFF1Pub {
    static constexpr bool PERM = true;
    bf16_t* O; const float* ssq; unsigned* ready; int row_off, pm_off;
    __device__ __forceinline__ void operator()(const f32x4 (&acc)[2][2][4][2], const Unit& u, int wr, int wc, int fr, int fq) const {
        const __amdgpu_buffer_rsrc_t rsrc = __builtin_amdgcn_make_buffer_rsrc((void*)O, 0, T_ALL * DFF * 2, 0x00020000);
        const int row0 = row_off + u.pm * 256 + wr * 64 + fr, col0 = u.pn * 256 + wc * 32 + 8 * fq;
#pragma unroll
        for (int ai = 0; ai < 2; ++ai)
#pragma unroll
            for (int m = 0; m < 4; ++m) {
                const int row = row0 + ai * 128 + m * 16; const float rs = row_rstd(ssq, row);
#pragma unroll
                for (int bj = 0; bj < 2; ++bj) { f32x4 v0 = acc[ai][bj][m][0] * rs, v1 = acc[ai][bj][m][1] * rs;
#pragma unroll
                    for (int j = 0; j < 4; ++j) { const float a = fmaxf(v0[j], 0.f), b = fmaxf(v1[j], 0.f); v0[j] = a * a; v1[j] = b * b; }
                    __builtin_amdgcn_raw_buffer_store_b128(pack8(v0, v1), rsrc, (unsigned)(((size_t)row * DFF + col0 + bj * 128) * 2), 0, 16  ); }
            }
        asm volatile("s_waitcnt vmcnt(0)" ::: "memory");
        if (fr == 0 && fq == 0) (void)__hip_atomic_fetch_add(ready + 64 * (pm_off + u.pm), 1u, __ATOMIC_RELAXED, __HIP_MEMORY_SCOPE_AGENT);
    }
};
struct EpiLora {
    static constexpr bool PERM = true;
    bf16_t *sw, *sa, *sg;
    __device__ __forceinline__ void operator()(const f32x4 (&acc)[2][2][4][2], const Unit& u, int wr, int wc, int fr, int fq) const {
        const int sel = u.pn >> 1; const int row0 = u.pm * 256 + wr * 64 + fr, col0 = (u.pn & 1) * 256 + wc * 32 + 8 * fq;
        unsigned long long o_ = (unsigned long long)sw; if (sel == 1) o_ = (unsigned long long)sa; asm volatile("" : "+s"(o_)); if (sel == 2) o_ = (unsigned long long)sg; asm volatile("" : "+s"(o_));
        bf16_t* O = (bf16_t*)o_;
#pragma unroll
        for (int ai = 0; ai < 2; ++ai)
#pragma unroll
            for (int m = 0; m < 4; ++m) {
                bf16_t* rowp = O + (size_t)(row0 + ai * 128 + m * 16) * 512 + col0;
#pragma unroll
                for (int bj = 0; bj < 2; ++bj) *(u32x4*)(rowp + bj * 128) = pack8(acc[ai][bj][m][0], acc[ai][bj][m][1]);
            }
    }
};
struct EpiPool {
    static constexpr bool PERM = true;
    bf16_t* z; const float* scale;
    __device__ __forceinline__ void operator()(const f32x4 (&acc)[2][2][4][2], const Unit& u, int wr, int wc, int fr, int fq) const {
        const int row0 = u.pm * 256 + wr * 64 + fr, col0 = u.pn * 256 + wc * 32 + 8 * fq;
        f32x4 bv[2][2];
#pragma unroll
        for (int bj = 0; bj < 2; ++bj)
#pragma unroll
            for (int n = 0; n < 2; ++n) bv[bj][n] = *(const f32x4*)(scale + col0 + bj * 128 + 4 * n);
#pragma unroll
        for (int ai = 0; ai < 2; ++ai)
#pragma unroll
            for (int m = 0; m < 4; ++m) {
                bf16_t* rowp = z + (size_t)(row0 + ai * 128 + m * 16) * DIN + O_U + col0;
#pragma unroll
                for (int bj = 0; bj < 2; ++bj) *(u32x4*)(rowp + bj * 128) = pack8(acc[ai][bj][m][0] * bv[bj][0], acc[ai][bj][m][1] * bv[bj][1]);
            }
    }
};
template <int MODE> struct EpiGate {
    static constexpr bool PERM = true;
    bf16_t* z;
    __device__ __forceinline__ void operator()(const f32x4 (&acc)[2][2][4][2], const Unit& u, int wr, int wc, int fr, int fq) const {
        const int row0 = u.pm * 256 + wr * 64 + fr, col0 = u.pn * 256 + wc * 32 + 8 * fq;
#pragma unroll
        for (int ai = 0; ai < 2; ++ai)
#pragma unroll
            for (int m = 0; m < 4; ++m) {
                bf16_t* rowp = z + (size_t)(row0 + ai * 128 + m * 16) * DIN + col0;
#pragma unroll
                for (int bj = 0; bj < 2; ++bj) {
                    const u32x4 gw = *(const u32x4*)(rowp + (MODE == 0 ? O_GB : O_GA) + bj * 128);
                    f32x4 g0, g1; unpack8(gw, g0, g1);
                    f32x4 v0, v1;
#pragma unroll
                    for (int j = 0; j < 4; ++j) { v0[j] = sigmoidf_(g0[j]) * acc[ai][bj][m][0][j]; v1[j] = sigmoidf_(g1[j]) * acc[ai][bj][m][1][j]; }
                    if (MODE == 1) { const u32x4 mw = *(const u32x4*)(rowp + bj * 128); f32x4 m0, m1; unpack8(mw, m0, m1); v0 += m0; v1 += m1; }
                    *(u32x4*)(rowp + bj * 128) = pack8(v0, v1); }
            }
    }
};
struct EpiMergePub {
    static constexpr bool PERM = true;
    bf16_t* z; unsigned* ready; int row_off, pm_off;
    __device__ __forceinline__ void operator()(const f32x4 (&acc)[2][2][4][2], const Unit& u, int wr, int wc, int fr, int fq) const {
        const __amdgpu_buffer_rsrc_t rsrc = __builtin_amdgcn_make_buffer_rsrc((void*)z, 0, T_ALL * DIN * 2, 0x00020000);
        const int row0 = row_off + u.pm * 256 + wr * 64 + fr, col0 = u.pn * 256 + wc * 32 + 8 * fq;
#pragma unroll
        for (int ai = 0; ai < 2; ++ai)
#pragma unroll
            for (int m = 0; m < 4; ++m) {
                const int row = row0 + ai * 128 + m * 16;
                const bf16_t* rowp = z + (size_t)row * DIN + col0;
#pragma unroll
                for (int bj = 0; bj < 2; ++bj) {
                    const u32x4 gw = *(const u32x4*)(rowp + O_GA + bj * 128);
                    f32x4 g0, g1; unpack8(gw, g0, g1);
                    f32x4 v0, v1;
#pragma unroll
                    for (int j = 0; j < 4; ++j) { v0[j] = sigmoidf_(g0[j]) * acc[ai][bj][m][0][j]; v1[j] = sigmoidf_(g1[j]) * acc[ai][bj][m][1][j]; }
                    const u32x4 mw = *(const u32x4*)(rowp + bj * 128); f32x4 m0, m1; unpack8(mw, m0, m1); v0 += m0; v1 += m1;
                    __builtin_amdgcn_raw_buffer_store_b128(pack8(v0, v1), rsrc, (unsigned)(((size_t)row * DIN + col0 + bj * 128) * 2), 0, 16  ); }
            }
        asm volatile("s_waitcnt vmcnt(0)" ::: "memory");
        if (fr == 0 && fq == 0) (void)__hip_atomic_fetch_add(ready + 64 * (pm_off + u.pm), 1u, __ATOMIC_RELAXED, __HIP_MEMORY_SCOPE_AGENT);
    }
};
struct EpiRes {
    static constexpr bool PERM = false;
    const float* xoldA; const float* xoldB;
    float* xf; bf16_t* xb; float* ssq;
    __device__ __forceinline__ void operator()(const f32x4 (&acc)[2][2][4][2], const Unit& u, int wr, int wc, int fr, int fq) const {
        const int row0 = u.pm * 256 + wr * 64 + fr, col0 = u.pn * 256 + wc * 32 + 4 * fq;
        const float* xo = (u.pm < 64) ? xoldA : (xoldB - (size_t)T_P * DM);
#pragma unroll
        for (int ai = 0; ai < 2; ++ai)
#pragma unroll
            for (int m = 0; m < 4; ++m) {
                const int row = row0 + ai * 128 + m * 16; const size_t ro = (size_t)row * DM + col0;
                float s = 0.f;
#pragma unroll
                for (int bj = 0; bj < 2; ++bj)
#pragma unroll
                    for (int n = 0; n < 2; ++n) {
                        const size_t o = ro + bj * 128 + n * 16;
                        const f32x4 xn = *(const f32x4*)(xo + o) + acc[ai][bj][m][n];
                        *(f32x4*)(xf + o) = xn;
                        u32x2 w; w.x = pk2(xn[0], xn[1]); w.y = pk2(xn[2], xn[3]); *(u32x2*)(xb + o) = w;
                        s += (xn[0] * xn[0] + xn[1] * xn[1]) + (xn[2] * xn[2] + xn[3] * xn[3]);
                    }
                s += __shfl_xor(s, 16); s += __shfl_xor(s, 32);
                if (fq == 0) ssq[(size_t)row * 16 + u.pn * 4 + wc] = s;
            }
    }
};

#define RAW_BARRIER() do { asm volatile("s_waitcnt lgkmcnt(0)" ::: "memory"); __builtin_amdgcn_s_barrier(); asm volatile("" ::: "memory"); } while (0)
__device__ void transpose_convert(const float* src, int K, int N, const float* gain, bf16_t* dst, float* tile  , int wg0 = 0, int wgn = 0) {
    int tid_ = threadIdx.x; asm volatile("" : "+v"(tid_));
    const int tid = tid_, ntn = N / 64, ntiles = (K / 64) * ntn, nwg = wgn > 0 ? wgn : (int)gridDim.x - wg0;
    if ((int)blockIdx.x < wg0 || (int)blockIdx.x >= wg0 + nwg) return;
    const int r = tid >> 4, c4 = (tid & 15) * 4, n = tid >> 3, k8 = (tid & 7) * 8;
    int t = (int)blockIdx.x - wg0;
    f32x4 v0, v1; float g0 = 1.f, g1 = 1.f;
    if (t < ntiles) { const int k0 = (t / ntn) * 64, n0 = (t % ntn) * 64;
        v0 = *(const f32x4*)(src + (size_t)(k0 + r) * N + n0 + c4); v1 = *(const f32x4*)(src + (size_t)(k0 + r + 32) * N + n0 + c4);
        if (gain) { g0 = gain[k0 + r]; g1 = gain[k0 + r + 32]; } }
    for (; t < ntiles; t += nwg) {
        const int k0 = (t / ntn) * 64, n0 = (t % ntn) * 64;
        tile[r * 65 + c4 + 0] = v0[0] * g0; tile[r * 65 + c4 + 1] = v0[1] * g0; tile[r * 65 + c4 + 2] = v0[2] * g0; tile[r * 65 + c4 + 3] = v0[3] * g0;
        tile[(r + 32) * 65 + c4 + 0] = v1[0] * g1; tile[(r + 32) * 65 + c4 + 1] = v1[1] * g1; tile[(r + 32) * 65 + c4 + 2] = v1[2] * g1; tile[(r + 32) * 65 + c4 + 3] = v1[3] * g1;
        const int tn = t + nwg;
        if (tn < ntiles) { const int k1 = (tn / ntn) * 64, n1 = (tn % ntn) * 64;
            v0 = *(const f32x4*)(src + (size_t)(k1 + r) * N + n1 + c4); v1 = *(const f32x4*)(src + (size_t)(k1 + r + 32) * N + n1 + c4);
            if (gain) { g0 = gain[k1 + r]; g1 = gain[k1 + r + 32]; } }
        RAW_BARRIER();
        { u32x4 w;
          w.x = pk2(tile[(k8 + 0) * 65 + n], tile[(k8 + 1) * 65 + n]); w.y = pk2(tile[(k8 + 2) * 65 + n], tile[(k8 + 3) * 65 + n]);
          w.z = pk2(tile[(k8 + 4) * 65 + n], tile[(k8 + 5) * 65 + n]); w.w = pk2(tile[(k8 + 6) * 65 + n], tile[(k8 + 7) * 65 + n]);
          *(u32x4*)(dst + (size_t)(n0 + n) * K + k0 + k8) = w; }
        RAW_BARRIER();
    }
}
__device__ void convert_lora_pool(int l, int wg0 = 0, int wgn = 0) {
    const int nwg_ = wgn > 0 ? wgn : (int)gridDim.x - wg0;
    if ((int)blockIdx.x < wg0 || (int)blockIdx.x >= wg0 + nwg_) return;
    const int gtid = ((int)blockIdx.x - wg0) * 512 + threadIdx.x, nth = nwg_ * 512;
    { const float* wd = KP(w_decay2) + (size_t)l * 64 * 512; const float* wa = KP(w_a2) + (size_t)l * 64 * 512; const float* wg = KP(w_g2) + (size_t)l * 128 * 512;
      bf16_t* LoraT = KP(LoraT);
      for (int i = gtid; i < 1536 * 256; i += nth) { const int n = i >> 8, k = i & 255; float v = 0.f;
        if (n < 512) { if (k < 64) v = wd[k * 512 + n]; }
        else if (n < 1024) { if (k >= 64 && k < 128) v = wa[(k - 64) * 512 + (n - 512)]; }
        else { if (k >= 128) v = wg[(k - 128) * 512 + (n - 1024)]; }
        LoraT[i] = f2bf(v); } }
    { const float* wp = KP(w_pool) + (size_t)l * 4 * 128 * 128; bf16_t* PoolT = KP(PoolT);
      for (int i = gtid; i < 512 * 512; i += nth) { const int n = i >> 9, k = i & 511; const int g = n >> 7, d = n & 127; float v = 0.f;
        if ((k >> 7) == g) v = wp[(g * 128 + (k & 127)) * 128 + d];
        PoolT[i] = f2bf(v); } }
}
__device__ void convert_rest(int l, float* tile) {
    transpose_convert(KP(w_b_up) + (size_t)l * 512 * DM, 512, DM, nullptr, KP(BupT), tile);
    transpose_convert(KP(w_a_up) + (size_t)l * 512 * DM, 512, DM, nullptr, KP(AupT), tile);
    transpose_convert(KP(w_o) + (size_t)l * DM * DM, DM, DM, nullptr, KP(WoT), tile);
    transpose_convert(KP(w_ff1) + (size_t)l * DM * DFF, DM, DFF, KP(norm2_g) + (size_t)l * DM, KP(Wff1T), tile);
    transpose_convert(KP(w_ff2) + (size_t)l * DFF * DM, DFF, DM, nullptr, KP(Wff2T), tile);
}

__device__ void phase_prologue(float* tile) {
    transpose_convert(KP(w_in), DM, DIN, KP(norm1_g), KP(WinT), tile);
    convert_lora_pool(0);
    const float* x_prompt = KP(x_prompt); const float* x_sample = KP(x_sample); bf16_t* xb = KP(xb); float* ssq = KP(ssq);
    const int lane = threadIdx.x & 63, gw = blockIdx.x * 8 + (threadIdx.x >> 6), nw = gridDim.x * 8;
    for (int row = gw; row < T_ALL; row += nw) {
        const float* xr = row < T_P ? x_prompt + (size_t)row * DM : x_sample + (size_t)(row - T_P) * DM;
        float s = 0.f;
#pragma unroll
        for (int i = 0; i < 4; ++i) { const int c = i * 256 + lane * 4; const f32x4 v = *(const f32x4*)(xr + c);
            s += (v[0] * v[0] + v[1] * v[1]) + (v[2] * v[2] + v[3] * v[3]);
            u32x2 w; w.x = pk2(v[0], v[1]); w.y = pk2(v[2], v[3]); *(u32x2*)(xb + (size_t)row * DM + c) = w; }
#pragma unroll
        for (int o = 32; o >= 1; o >>= 1) s += __shfl_xor(s, o);
        if (lane < 16) ssq[(size_t)row * 16 + lane] = lane == 0 ? s : 0.f;
    }
}

struct Tok { int is_s, seq, t; };
__device__ __forceinline__ Tok tok_decode(int tok) { Tok r; if (tok < T_P) { r.is_s = 0; r.seq = tok >> 11; r.t = tok & 2047; } else { r.is_s = 1; r.seq = (tok - T_P) >> 3; r.t = (tok - T_P) & 7; } return r; }

__device__ void phase_e1(int l) {
    const int gtid = blockIdx.x * 512 + threadIdx.x, nth = gridDim.x * 512;
    const bf16_t* z = KP(z); bf16_t* pbuf = KP(xb);
    bf16_t* Lb = KP(L);
    const float* mu = KP(mu_shift) + (size_t)l * DSH;
    const float* st_shift = KP(state_shift) + (size_t)l * NSB * DSH;
    const float* st_pool = KP(state_pool) + (size_t)l * NSB * 15 * 512;
    float* out = KP(out);
    for (int it = gtid; it < T_ALL * 32; it += nth) {
        const int tok = it >> 5, v = it & 31; const Tok tk = tok_decode(tok);
        const int c = O_LORA + v * 8; const bf16_t* zr = z + (size_t)tok * DIN + c;
        f32x4 x0, x1, p0, p1; unpack8(*(const u32x4*)zr, x0, x1);
        if (tk.t > 0) unpack8(*(const u32x4*)(zr - DIN), p0, p1);
        else if (tk.is_s) { const float* sp = st_shift + (size_t)tk.seq * DSH + c; p0 = *(const f32x4*)sp; p1 = *(const f32x4*)(sp + 4); }
        else { p0 = (f32x4){0.f, 0.f, 0.f, 0.f}; p1 = p0; }
        const f32x4 m0 = *(const f32x4*)(mu + c), m1 = *(const f32x4*)(mu + c + 4);
        x0 = x0 + (p0 - x0) * m0; x1 = x1 + (p1 - x1) * m1;
        if (v < 8) {
#pragma unroll
            for (int j = 0; j < 4; ++j) { x0[j] = tanhf_(x0[j]); x1[j] = tanhf_(x1[j]); } }
        else if (v >= 16) {
#pragma unroll
            for (int j = 0; j < 4; ++j) { x0[j] = sigmoidf_(x0[j]); x1[j] = sigmoidf_(x1[j]); } }
        *(u32x4*)(Lb + (size_t)tok * 256 + v * 8) = pack8(x0, x1);
    }
    for (int it = gtid; it < T_ALL * 64; it += nth) {
        const int gi = (it >> 6) & 3, tok = (it >> 8) * 4 + ((it >> 4) & 3), c = gi * 128 + (it & 15) * 8, win = 2 << gi; const Tok tk = tok_decode(tok);
        const bf16_t* zr = z + (size_t)tok * DIN + O_U + c;
        f32x4 u0, u1; unpack8(*(const u32x4*)zr, u0, u1);
        f32x4 s0 = u0, s1 = u1;
#define POOL_ROWS(W) { u32x4 rw[W - 1]; \
            _Pragma("unroll") for (int j = 1; j < W; ++j) rw[j - 1] = *(const u32x4*)(zr - (size_t)(tk.t - j >= 0 ? j : 0) * DIN); \
            _Pragma("unroll") for (int j = 1; j < W; ++j) { f32x4 a0, a1; unpack8(rw[j - 1], a0, a1); const float mk = (tk.t - j >= 0) ? 1.0f : 0.0f; s0 += a0 * mk; s1 += a1 * mk; } }
        if (gi == 0) POOL_ROWS(2) else if (gi == 1) POOL_ROWS(4) else if (gi == 2) POOL_ROWS(8) else POOL_ROWS(16)
#undef POOL_ROWS
        if (tk.is_s) {
            for (int j = tk.t + 1; j < win; ++j) { const float* sp = st_pool + ((size_t)tk.seq * 15 + (15 + tk.t - j)) * 512 + c; s0 += *(const f32x4*)sp; s1 += *(const f32x4*)(sp + 4); }
        }
        const int cnt = tk.is_s ? win : min(tk.t + 1, win);
        const float inv = 1.0f / (float)cnt;
        s0 = s0 * inv - u0; s1 = s1 * inv - u1;
        *(u32x4*)(pbuf + (size_t)tok * 512 + c) = pack8(s0, s1);
    }
    for (int i = gtid; i < (NB + NSB) * DSH; i += nth) {
        const int sq = i / DSH, c = i - sq * DSH;
        if (sq < NB) out[OUT_PSHIFT + ((size_t)l * NB + sq) * DSH + c] = bf2f(z[(size_t)(sq * SEQ + SEQ - 1) * DIN + c]);
        else { const int sb = sq - NB; out[OUT_SSHIFT + ((size_t)l * NSB + sb) * DSH + c] = bf2f(z[(size_t)(T_P + sb * DSEQ + DSEQ - 1) * DIN + c]); }
    }
    for (int i = gtid; i < (NB + NSB) * 15 * 512; i += nth) {
        const int sq = i / (15 * 512), r = (i / 512) % 15, c = i & 511;
        if (sq < NB) out[OUT_PPOOL + (((size_t)l * NB + sq) * 15 + r) * 512 + c] = bf2f(z[(size_t)(sq * SEQ + SEQ - 15 + r) * DIN + O_U + c]);
        else { const int sb = sq - NB; float v;
            if (r < 7) v = st_pool[((size_t)sb * 15 + (8 + r)) * 512 + c];
            else v = bf2f(z[(size_t)(T_P + sb * DSEQ + (r - 7)) * DIN + O_U + c]);
            out[OUT_SPOOL + (((size_t)l * NSB + sb) * 15 + r) * 512 + c] = v; }
    }
}

__device__ __forceinline__ f32x4 ld_bf4(const bf16_t* p) { const u32x2 w = *(const u32x2*)p; return (f32x4){bflo(w.x), bfhi(w.x), bflo(w.y), bfhi(w.y)}; }

__device__ void phase_e2(int l, int wg0) {
    if ((int)blockIdx.x < wg0) return;
    const int gtid = ((int)blockIdx.x - wg0) * 512 + threadIdx.x, nth = ((int)gridDim.x - wg0) * 512;
    const bf16_t* ybuf = KP(xb); bf16_t* ya = KP(xb) + (size_t)T_ALL * 512;
    const bf16_t* z = KP(z); const bf16_t* sc_g = KP(sc_g); const float* rkb = KP(rk);
    const float* mu = KP(mu_shift) + (size_t)l * DSH + 1024;
    const float* st_shift = KP(state_shift) + (size_t)l * NSB * DSH;
    const float* lng = KP(ln_x_g) + (size_t)l * 512; const float* lnb = KP(ln_x_b) + (size_t)l * 512;
    for (int it0 = gtid; it0 < T_ALL * 128; it0 += 2 * nth) {
        f32x4 y[2], v[2], vp[2], g[2], m4[2], lg[2], lb[2]; float rk[2]; int tokv[2], cv[2]; bool ok[2];
#pragma unroll
        for (int q = 0; q < 2; ++q) {
            const int it = it0 + q * nth; ok[q] = it < T_ALL * 128; const int itc = ok[q] ? it : it0;
            const int tok = itc >> 7, c = (itc & 127) * 4, h = c >> 6; const Tok tk = tok_decode(tok); tokv[q] = tok; cv[q] = c;
            y[q] = ld_bf4(ybuf + (size_t)tok * 512 + c);
            const bf16_t* zr = z + (size_t)tok * DIN + 1024 + c;
            v[q] = ld_bf4(zr);
            if (tk.t > 0) vp[q] = ld_bf4(zr - DIN);
            else if (tk.is_s) vp[q] = *(const f32x4*)(st_shift + (size_t)tk.seq * DSH + 1024 + c);
            else vp[q] = (f32x4){0.f, 0.f, 0.f, 0.f};
            m4[q] = *(const f32x4*)(mu + c); rk[q] = rkb[(size_t)tok * 8 + h];
            lg[q] = *(const f32x4*)(lng + c); lb[q] = *(const f32x4*)(lnb + c);
            g[q] = ld_bf4(sc_g + (size_t)tok * 512 + c);
        }
#pragma unroll
        for (int q = 0; q < 2; ++q) {
            f32x4 yy = y[q];
            const float mean = allsum16((yy[0] + yy[1]) + (yy[2] + yy[3])) * (1.0f / 64.0f);
            yy = yy - mean;
            const float var = allsum16((yy[0] * yy[0] + yy[1] * yy[1]) + (yy[2] * yy[2] + yy[3] * yy[3])) * (1.0f / 64.0f);
            const float rstd = rsqrtf(var + 64e-5f);
            const f32x4 vv = v[q] + (vp[q] - v[q]) * m4[q];
            const f32x4 o = ((yy * rstd) * lg[q] + lb[q] + vv * rk[q]) * g[q];
            u32x2 w; w.x = pk2(o[0], o[1]); w.y = pk2(o[2], o[3]);
            if (ok[q]) *(u32x2*)(ya + (size_t)tokv[q] * 512 + cv[q]) = w;
        }
    }
}

__device__ void phase_final() {
    float* out = KP(out); const float* ssq = KP(ssq); const float* fg = KP(final_g);
    const int lane = threadIdx.x & 63, gw = blockIdx.x * 8 + (threadIdx.x >> 6), nw = gridDim.x * 8;
    for (int row = gw; row < T_ALL; row += nw) {
        const float rs = row_rstd(ssq, row);
        float* xr = out + (size_t)row * DM;
#pragma unroll
        for (int i = 0; i < 4; ++i) { const int c = i * 256 + lane * 4; const f32x4 v = *(const f32x4*)(xr + c); const f32x4 g = *(const f32x4*)(fg + c);
            *(f32x4*)(xr + c) = v * rs * g; }
    }
}

constexpr int SC_TOKB = 1344;
constexpr int SC_CH = 48;
constexpr int SC_NCH = (SEQ + SC_CH - 1) / SC_CH;
constexpr int SC_BUFB = SC_CH * SC_TOKB;
constexpr int NJOBS = 256 + 4096;
struct Job { int is_s, seq, h, rs, tok0, nsteps, first, last; };
__device__ __forceinline__ Job job_decode(int J, int ci) {
    Job j;
    if (J < 256) { const int pair = J >> 2; j.is_s = 0; j.seq = pair >> 3; j.h = pair & 7; j.rs = J & 3; j.tok0 = j.seq * SEQ + ci * SC_CH; j.nsteps = (SEQ - ci * SC_CH) < SC_CH ? (SEQ - ci * SC_CH) : SC_CH; j.first = ci == 0; j.last = ci == SC_NCH - 1; }
    else { const int Js = J - 256, pair = Js >> 2; j.is_s = 1; j.seq = pair >> 3; j.h = pair & 7; j.rs = Js & 3; j.tok0 = T_P + j.seq * DSEQ; j.nsteps = 8; j.first = 1; j.last = 1; }
    return j;
}
struct ScanPtrs { const bf16_t *z, *sw, *sa; const float *st_shift, *mu, *k_k, *k_a, *r_k, *decay0, *a0; float* rk; };

struct LStage { u32x2 r, k, v, rp, kp, vp, sw, sa; f32x4 fr, fk, fv; };
__device__ __forceinline__ void scan_issue(const ScanPtrs& Q, int J, int ci, int ltid, LStage& L, int toff) {
    const Job jb = job_decode(J, ci);
    const int tt = (ltid >> 4) + toff, c = (ltid & 15) * 4;
    if (tt < jb.nsteps) {
        const int tok = jb.tok0 + tt; const int tseq = jb.is_s ? tt : ci * SC_CH + tt;
        const int gc = jb.h * 64 + c;
        const bf16_t* zr = Q.z + (size_t)tok * DIN + gc;
        L.r = *(const u32x2*)zr; L.k = *(const u32x2*)(zr + 512); L.v = *(const u32x2*)(zr + 1024);
        if (tseq > 0) { L.rp = *(const u32x2*)(zr - DIN); L.kp = *(const u32x2*)(zr - DIN + 512); L.vp = *(const u32x2*)(zr - DIN + 1024); }
        else if (jb.is_s) { const float* sp = Q.st_shift + (size_t)jb.seq * DSH + gc; L.fr = *(const f32x4*)sp; L.fk = *(const f32x4*)(sp + 512); L.fv = *(const f32x4*)(sp + 1024); }
        L.sw = *(const u32x2*)(Q.sw + (size_t)tok * 512 + gc); L.sa = *(const u32x2*)(Q.sa + (size_t)tok * 512 + gc);
    }
}
__device__ __forceinline__ f32x4 cv_bf4(const u32x2 w) { return (f32x4){bflo(w.x), bfhi(w.x), bflo(w.y), bfhi(w.y)}; }
__device__ __forceinline__ void scan_finish(const ScanPtrs& Q, int J, int ci, unsigned char* buf, int ltid, const LStage& L, int toff) {
    const Job jb = job_decode(J, ci);
    const int tt = (ltid >> 4) + toff, c = (ltid & 15) * 4;
    if (tt < jb.nsteps) {
        const int tok = jb.tok0 + tt; const int tseq = jb.is_s ? tt : ci * SC_CH + tt;
        const int gc = jb.h * 64 + c;
        f32x4 r = cv_bf4(L.r), k0 = cv_bf4(L.k), v = cv_bf4(L.v), rp, kp, vp;
        if (tseq > 0) { rp = cv_bf4(L.rp); kp = cv_bf4(L.kp); vp = cv_bf4(L.vp); }
        else if (jb.is_s) { rp = L.fr; kp = L.fk; vp = L.fv; }
        else { rp = (f32x4){0.f, 0.f, 0.f, 0.f}; kp = rp; vp = rp; }
        const float* mu = Q.mu + gc;
        r = r + (rp - r) * *(const f32x4*)mu; k0 = k0 + (kp - k0) * *(const f32x4*)(mu + 512); v = v + (vp - v) * *(const f32x4*)(mu + 1024);
        const f32x4 kk = k0 * *(const f32x4*)(Q.k_k + gc);
        const float ss = allsum16((kk[0] * kk[0] + kk[1] * kk[1]) + (kk[2] * kk[2] + kk[3] * kk[3]));
        const float inv = 1.0f / fmaxf(sqrtf(ss), 1e-12f);
        const f32x4 kkn = kk * inv;
        const f32x4 dw = cv_bf4(L.sw) + *(const f32x4*)(Q.decay0 + gc);
        const f32x4 da = cv_bf4(L.sa) + *(const f32x4*)(Q.a0 + gc);
        f32x4 dec, ain;
#pragma unroll
        for (int j = 0; j < 4; ++j) { dec[j] = __expf(-0.60653066f * sigmoidf_(dw[j])); ain[j] = sigmoidf_(da[j]); }
        const f32x4 ka = *(const f32x4*)(Q.k_a + gc);
        const f32x4 kf = k0 * (1.0f + (ain - 1.0f) * ka);
        const f32x4 rkw = *(const f32x4*)(Q.r_k + gc);
        const f32x4 pr = r * kf * rkw;
        const float rk = allsum16((pr[0] + pr[1]) + (pr[2] + pr[3]));
        unsigned char* tb = buf + tt * SC_TOKB + c * 4;
        *(f32x4*)(tb) = -kkn; *(f32x4*)(tb + 256) = dec; *(f32x4*)(tb + 512) = kkn * ain; *(f32x4*)(tb + 768) = kf; *(f32x4*)(tb + 1024) = r;
        if ((c >> 4) == jb.rs) *(f32x4*)(buf + tt * SC_TOKB + 1280 + (c & 15) * 4) = v;
        if (jb.rs == 0 && c == 0) Q.rk[(size_t)tok * 8 + jb.h] = rk;
    }
}
#define SC_BARRIER() do { asm volatile("s_waitcnt lgkmcnt(0)" ::: "memory"); __builtin_amdgcn_s_barrier(); asm volatile("" ::: "memory"); } while (0)
#define SC_ADV(J_, c_) do { if ((J_) < NJOBS) { if (++(c_) >= ((J_) < 256 ? SC_NCH : 1)) { (J_) += G; (c_) = 0; } } } while (0)

__device__ void phase_scan(int l, unsigned char* lds) {
    int tid_ = threadIdx.x; asm volatile("" : "+v"(tid_));
    const int tid = tid_, wid = tid >> 6, lane = tid & 63, G = gridDim.x;
    const bool loader = wid >= 4;
    if (!loader) __builtin_amdgcn_s_setprio(3);
    ScanPtrs Q;
    Q.z = KP(z); Q.sw = KP(xb) + (size_t)T_ALL * 512; Q.sa = KP(sc_a); Q.st_shift = KP(state_shift) + (size_t)l * NSB * DSH; Q.mu = KP(mu_shift) + (size_t)l * DSH;
    Q.k_k = KP(k_k) + (size_t)l * 512; Q.k_a = KP(k_a) + (size_t)l * 512; Q.r_k = KP(r_k) + (size_t)l * 512; Q.decay0 = KP(decay0) + (size_t)l * 512; Q.a0 = KP(a0) + (size_t)l * 512; Q.rk = KP(rk);
    bf16_t* ybuf = KP(xb);
    const float* st_wkv = KP(state_wkv); float* out = KP(out);
    int J = blockIdx.x, ci = 0, it = 0;
    int Ji = J, cis = 0;
    int Jg = J, cg_ = 0;
    LStage L, L2, L3;
    f32x2 s01 = (f32x2){0.f, 0.f}, s23 = s01;
    f32x4 s_pref = (f32x4){0.f, 0.f, 0.f, 0.f};
    if (!loader && J >= 256 && J < NJOBS) { const Job j0 = job_decode(J, 0); s_pref = *(const f32x4*)(st_wkv + (((((size_t)l * NSB + j0.seq) * 8 + j0.h) * 64 + j0.rs * 16 + (wid * 4 + (lane >> 4))) * 64 + (lane & 15) * 4)); }
#define SC_ISSUE3(J_, c_) do { scan_issue(Q, J_, c_, tid - 256, L, 0); scan_issue(Q, J_, c_, tid - 256, L2, 16); scan_issue(Q, J_, c_, tid - 256, L3, 32); } while (0)
#define SC_FINISH3(J_, c_, b_) do { scan_finish(Q, J_, c_, b_, tid - 256, L, 0); scan_finish(Q, J_, c_, b_, tid - 256, L2, 16); scan_finish(Q, J_, c_, b_, tid - 256, L3, 32); } while (0)
    if (loader) {
        if (Ji < NJOBS) { SC_ISSUE3(Ji, cis); SC_FINISH3(Ji, cis, lds); }
        SC_ADV(Ji, cis); SC_ADV(Jg, cg_);
        if (Ji < NJOBS) SC_ISSUE3(Ji, cis);
        SC_ADV(Ji, cis);
    }
    SC_BARRIER();
    while (J < NJOBS) {
        int Jn = J, cn = ci; SC_ADV(Jn, cn);
        const unsigned char* buf = lds + (it & 1) * SC_BUFB;
        if (loader) {
            if (Jg < NJOBS) SC_FINISH3(Jg, cg_, lds + ((it + 1) & 1) * SC_BUFB);
            SC_ADV(Jg, cg_);
            if (Ji < NJOBS) SC_ISSUE3(Ji, cis);
            SC_ADV(Ji, cis);
        } else {
            const Job jb = job_decode(J, ci);
            const int rl = wid * 4 + (lane >> 4), row = jb.rs * 16 + rl, c0 = (lane & 15) * 4;
            const size_t sidx = ((((size_t)l * (jb.is_s ? NSB : NB) + jb.seq) * 8 + jb.h) * 64 + row) * 64 + c0;
            if (jb.first) { s01 = (f32x2){0.f, 0.f}; s23 = s01;
                if (jb.is_s) { asm volatile("" ::: "memory");
                    s01 = (f32x2){s_pref[0], s_pref[1]}; s23 = (f32x2){s_pref[2], s_pref[3]}; } }
            if (Jn < NJOBS && Jn >= 256 && cn == 0 && Jn != J) { const Job jn = job_decode(Jn, 0);
                s_pref = *(const f32x4*)(st_wkv + (((((size_t)l * NSB + jn.seq) * 8 + jn.h) * 64 + jn.rs * 16 + rl) * 64 + c0)); }
            float yreg0 = 0.f, yreg1 = 0.f, yreg2 = 0.f;
            for (int t8 = 0; t8 < (jb.nsteps < 16 ? jb.nsteps : 16); t8 += 4) {
#pragma unroll
                for (int u = 0; u < 4; ++u) {
                    const int tt = t8 + u;
                    const unsigned char* tb = buf + tt * SC_TOKB + c0 * 4;
                    const f32x4 a = *(const f32x4*)(tb), w = *(const f32x4*)(tb + 256), b = *(const f32x4*)(tb + 512), k = *(const f32x4*)(tb + 768), r = *(const f32x4*)(tb + 1024);
                    const float v = *(const float*)(buf + tt * SC_TOKB + 1280 + rl * 4);
                    const f32x2 a01 = (f32x2){a[0], a[1]}, a23 = (f32x2){a[2], a[3]}, w01 = (f32x2){w[0], w[1]}, w23 = (f32x2){w[2], w[3]}, b01 = (f32x2){b[0], b[1]}, b23 = (f32x2){b[2], b[3]};
                    const f32x2 k01 = (f32x2){k[0], k[1]}, k23 = (f32x2){k[2], k[3]}, r01 = (f32x2){r[0], r[1]}, r23 = (f32x2){r[2], r[3]};
                    const f32x2 pa = s01 * a01 + s23 * a23;
                    const float sa = allsum16(pa.x + pa.y);
                    const f32x2 kv01 = k01 * v, kv23 = k23 * v;
                    s01 = s01 * w01 + (b01 * sa + kv01); s23 = s23 * w23 + (b23 * sa + kv23);
                    const f32x2 py = s01 * r01 + s23 * r23;
                    const float y = allsum16(py.x + py.y);
                    if ((lane & 15) == (tt & 15)) yreg0 = y;
                }
            }
            for (int t8 = 16; t8 < (jb.nsteps < 32 ? jb.nsteps : 32); t8 += 4) {
#pragma unroll
                for (int u = 0; u < 4; ++u) {
                    const int tt = t8 + u;
                    const unsigned char* tb = buf + tt * SC_TOKB + c0 * 4;
                    const f32x4 a = *(const f32x4*)(tb), w = *(const f32x4*)(tb + 256), b = *(const f32x4*)(tb + 512), k = *(const f32x4*)(tb + 768), r = *(const f32x4*)(tb + 1024);
                    const float v = *(const float*)(buf + tt * SC_TOKB + 1280 + rl * 4);
                    const f32x2 a01 = (f32x2){a[0], a[1]}, a23 = (f32x2){a[2], a[3]}, w01 = (f32x2){w[0], w[1]}, w23 = (f32x2){w[2], w[3]}, b01 = (f32x2){b[0], b[1]}, b23 = (f32x2){b[2], b[3]};
                    const f32x2 k01 = (f32x2){k[0], k[1]}, k23 = (f32x2){k[2], k[3]}, r01 = (f32x2){r[0], r[1]}, r23 = (f32x2){r[2], r[3]};
                    const f32x2 pa = s01 * a01 + s23 * a23;
                    const float sa = allsum16(pa.x + pa.y);
                    const f32x2 kv01 = k01 * v, kv23 = k23 * v;
                    s01 = s01 * w01 + (b01 * sa + kv01); s23 = s23 * w23 + (b23 * sa + kv23);
                    const f32x2 py = s01 * r01 + s23 * r23;
                    const float y = allsum16(py.x + py.y);
                    if ((lane & 15) == (tt & 15)) yreg1 = y;
                }
            }
            for (int t8 = 32; t8 < (jb.nsteps < 48 ? jb.nsteps : 48); t8 += 4) {
#pragma unroll
                for (int u = 0; u < 4; ++u) {
                    const int tt = t8 + u;
                    const unsigned char* tb = buf + tt * SC_TOKB + c0 * 4;
                    const f32x4 a = *(const f32x4*)(tb), w = *(const f32x4*)(tb + 256), b = *(const f32x4*)(tb + 512), k = *(const f32x4*)(tb + 768), r = *(const f32x4*)(tb + 1024);
                    const float v = *(const float*)(buf + tt * SC_TOKB + 1280 + rl * 4);
                    const f32x2 a01 = (f32x2){a[0], a[1]}, a23 = (f32x2){a[2], a[3]}, w01 = (f32x2){w[0], w[1]}, w23 = (f32x2){w[2], w[3]}, b01 = (f32x2){b[0], b[1]}, b23 = (f32x2){b[2], b[3]};
                    const f32x2 k01 = (f32x2){k[0], k[1]}, k23 = (f32x2){k[2], k[3]}, r01 = (f32x2){r[0], r[1]}, r23 = (f32x2){r[2], r[3]};
                    const f32x2 pa = s01 * a01 + s23 * a23;
                    const float sa = allsum16(pa.x + pa.y);
                    const f32x2 kv01 = k01 * v, kv23 = k23 * v;
                    s01 = s01 * w01 + (b01 * sa + kv01); s23 = s23 * w23 + (b23 * sa + kv23);
                    const f32x2 py = s01 * r01 + s23 * r23;
                    const float y = allsum16(py.x + py.y);
                    if ((lane & 15) == (tt & 15)) yreg2 = y;
                }
            }
            if ((lane & 15) < jb.nsteps) ybuf[(size_t)(jb.tok0 + (lane & 15)) * 512 + jb.h * 64 + row] = f2bf(yreg0);
            if (16 + (lane & 15) < jb.nsteps) ybuf[(size_t)(jb.tok0 + 16 + (lane & 15)) * 512 + jb.h * 64 + row] = f2bf(yreg1);
            if (32 + (lane & 15) < jb.nsteps) ybuf[(size_t)(jb.tok0 + 32 + (lane & 15)) * 512 + jb.h * 64 + row] = f2bf(yreg2);
            if (jb.last) *(f32x4*)(out + (jb.is_s ? OUT_SWKV : OUT_PWKV) + sidx) = (f32x4){s01.x, s01.y, s23.x, s23.y};
        }
        SC_BARRIER();
        J = Jn; ci = cn; ++it;
    }
    __builtin_amdgcn_s_setprio(0);
    __syncthreads();
}

#define XB_TMO      128
#define XB_XCNT(j)  (256  + 64 * (j))
#define XB_XSUB(j)  (1280 + 64 * (j))
#define XB_XGEN(j)  (2304 + 64 * (j))
#define XB_TOP      3328
#define XB_TOPGEN   3392
#define XCD_BAR_WORDS 3456
#define XB_SPIN_CAP (1u << 18)
__device__ __forceinline__ unsigned xb_ld(unsigned* p)              { return __hip_atomic_load(p, __ATOMIC_RELAXED, __HIP_MEMORY_SCOPE_AGENT); }
__device__ __forceinline__ unsigned xb_add(unsigned* p, unsigned v) { return __hip_atomic_fetch_add(p, v, __ATOMIC_RELAXED, __HIP_MEMORY_SCOPE_AGENT); }
__device__ __forceinline__ unsigned xb_xcc_id() { return (unsigned)__builtin_amdgcn_s_getreg((3 << 11) | 20) & 0xFu; }
#define XB_SPIN(cond, bar) do { unsigned _sp = 0; while (cond) { __builtin_amdgcn_s_sleep(1); \
    if ((++_sp & 255u) == 0u) { if (xb_ld(&(bar)[XB_TMO])) break; if (_sp > XB_SPIN_CAP) { atomicAdd(&(bar)[XB_TMO], 1u); break; } } } } while (0)
struct XcdBarrier { unsigned* bar; unsigned x; volatile LAS unsigned* st; };
__device__ __forceinline__ XcdBarrier xcd_barrier_post(unsigned* bar, volatile LAS unsigned* st) {
    XcdBarrier b; b.bar = bar; b.x = xb_xcc_id(); b.st = st;
    if (threadIdx.x == 0) (void)xb_add(&bar[XB_XCNT(b.x)], 1u);
    return b;
}
__device__ __forceinline__ void xcd_barrier_complete(unsigned* bar, unsigned x, unsigned& nloc, unsigned& nx) {
    const unsigned G = gridDim.x * gridDim.y * gridDim.z;
    unsigned sum, cnt, mine, sp = 0u;
    for (;;) {
        sum = 0u; cnt = 0u; mine = 0u;
#pragma unroll
        for (unsigned j = 0; j < 16; ++j) { const unsigned c = xb_ld(&bar[XB_XCNT(j)]); sum += c; cnt += (c > 0u) ? 1u : 0u; mine = (j == x) ? c : mine; }
        if (sum == G) break;
        __builtin_amdgcn_s_sleep(1);
        if ((++sp & 255u) == 0u) { if (xb_ld(&bar[XB_TMO])) break; if (sp > XB_SPIN_CAP) { atomicAdd(&bar[XB_TMO], 1u); break; } }
    }
    nloc = mine > 0u ? mine : 1u; nx = cnt > 0u ? cnt : 1u;
}
__device__ __forceinline__ void xcd_barrier(const XcdBarrier& b) {
    asm volatile("s_waitcnt vmcnt(0)" ::: "memory");
    __syncthreads();
    if (threadIdx.x == 0) {
        unsigned* bar = b.bar;
        __builtin_amdgcn_s_waitcnt(0);
        unsigned nloc = b.st[0], nx = b.st[1];
        if (nloc == 0u) { xcd_barrier_complete(bar, b.x, nloc, nx); b.st[0] = nloc; b.st[1] = nx; }
        const unsigned old = xb_add(&bar[XB_XSUB(b.x)], 1u);
        const unsigned gen = old / nloc;
        if (old + 1u == (gen + 1u) * nloc) {
            __builtin_amdgcn_fence(__ATOMIC_RELEASE, "agent");
            asm volatile("s_waitcnt vmcnt(0)" ::: "memory");
            const unsigned og = xb_add(&bar[XB_TOP], 1u);
            const unsigned tg = og / nx;
            if (og + 1u == (tg + 1u) * nx) xb_add(&bar[XB_TOPGEN], 1u);
            else XB_SPIN(xb_ld(&bar[XB_TOPGEN]) == tg, bar);
            __builtin_amdgcn_fence(__ATOMIC_ACQUIRE, "agent");
            xb_add(&bar[XB_XGEN(b.x)], 1u);
            asm volatile("s_waitcnt vmcnt(0)" ::: "memory");
        } else {
            XB_SPIN(xb_ld(&bar[XB_XGEN(b.x)]) == gen, bar);
            __builtin_amdgcn_fence(__ATOMIC_ACQUIRE, "agent");
            asm volatile("s_waitcnt vmcnt(0)" ::: "memory");
        }
    }
    __syncthreads();
}

struct EpiPartial {
    static constexpr bool PERM = false;
    float* part;
    __device__ __forceinline__ void operator()(const f32x4 (&acc)[2][2][4][2], const Unit& u, int wr, int wc, int fr, int fq) const {
        const int row0 = u.pm * 256 + wr * 64 + fr, col0 = u.pn * 256 + wc * 32 + 4 * fq;
#pragma unroll
        for (int ai = 0; ai < 2; ++ai)
#pragma unroll
            for (int m = 0; m < 4; ++m) { float* rowp = part + (size_t)(row0 + ai * 128 + m * 16) * DM + col0;
#pragma unroll
                for (int bj = 0; bj < 2; ++bj)
#pragma unroll
                    for (int n = 0; n < 2; ++n) *(f32x4*)(rowp + bj * 128 + n * 16) = acc[ai][bj][m][n]; }
    }
};
__device__ __forceinline__ void sample_splitk(LAS unsigned char* lds, const bf16_t* A, int lda, const bf16_t* Bt, int Ktot, const float* xold, float* xf_s, bf16_t* xb_s, float* ssq_s, float* part, unsigned* cnt, int cbase = 0, const unsigned* ready = nullptr, unsigned need = 0u, int npan = 0) {
    int G = gridDim.x, c = ((int)blockIdx.x - cbase + (int)gridDim.x) % (int)gridDim.x; asm volatile("" : "+s"(G), "+s"(c));
    const int Kq = Ktot >> 2;
    pg8::StaticOrder S;
#pragma unroll 1
    for (int kq = 0; kq < 4; ++kq) {
        pg8::Gemm g{A + (size_t)kq * Kq, Bt + (size_t)kq * Kq, 1024, DM, Kq, lda, Ktot};
        S.init(1024, DM, G, (c - 16 * kq + G) % G);
        EpiPartial E{part + (size_t)kq * 1024 * DM};
        pg8::gemm_phase(lds, g, S, E, ready, need, npan);
    }
    if (c < 64) {
        const int kq = c >> 4; Unit u; S.init(1024, DM, G, c & 15); S.next(0, u);
        unsigned* ctr = cnt + 64 * u.pm;
        asm volatile("s_waitcnt vmcnt(0)" ::: "memory");
        __syncthreads();
        if (threadIdx.x == 0) {
            __builtin_amdgcn_fence(__ATOMIC_RELEASE, "agent");
            asm volatile("s_waitcnt vmcnt(0)" ::: "memory");
            (void)__hip_atomic_fetch_add(ctr, 1u, __ATOMIC_RELAXED, __HIP_MEMORY_SCOPE_AGENT);
            unsigned sp = 0;
            while (__hip_atomic_load(ctr, __ATOMIC_RELAXED, __HIP_MEMORY_SCOPE_AGENT) < 16u) { __builtin_amdgcn_s_sleep(1); if (++sp > (1u << 22)) break; }
            __builtin_amdgcn_fence(__ATOMIC_ACQUIRE, "agent");
            asm volatile("s_waitcnt vmcnt(0)" ::: "memory");
        }
        __syncthreads();
        const int lane = threadIdx.x & 63, wv = threadIdx.x >> 6;
        const int rbase = u.pm * 256 + (kq * 4 + u.pn) * 16 + wv * 2;
#pragma unroll
        for (int rr = 0; rr < 2; ++rr) {
            const int row = rbase + rr; float sq = 0.f;
#pragma unroll
            for (int i = 0; i < 4; ++i) {
                const size_t o = (size_t)row * DM + i * 256 + lane * 4;
                f32x4 v = *(const f32x4*)(xold + o);
#pragma unroll
                for (int q = 0; q < 4; ++q) v += *(const f32x4*)(part + (size_t)q * 1024 * DM + o);
                *(f32x4*)(xf_s + o) = v;
                u32x2 w; w.x = pk2(v[0], v[1]); w.y = pk2(v[2], v[3]); *(u32x2*)(xb_s + o) = w;
                sq += (v[0] * v[0] + v[1] * v[1]) + (v[2] * v[2] + v[3] * v[3]);
            }
#pragma unroll
            for (int o = 32; o >= 1; o >>= 1) sq += __shfl_xor(sq, o);
            if (lane < 16) ssq_s[(size_t)row * 16 + lane] = lane == 0 ? sq : 0.f;
        }
    }
}

__device__ __forceinline__ void run_phase(int type, int l, unsigned char* shm) {
    LAS unsigned char* lds = (LAS unsigned char*)shm;
    pg8::StaticOrder S;
    int G = gridDim.x, c = blockIdx.x; asm volatile("" : "+s"(G), "+s"(c));
    if (type == 0) { phase_prologue((float*)shm); }
    else if (type == 1) {
        pg8::Gemm g{KP(xb), KP(WinT), T_ALL, DIN, DM, DM, DM}; S.init(T_ALL, DIN, G, c);
        EpiNormBf16<0> E{KP(z), DIN, KP(ssq)}; pg8::gemm_phase(lds, g, S, E);
        { const int w0 = (68 * 17) % G;
          if (l == 1) transpose_convert(KP(w_ff2) + (size_t)DFF * DM, DFF, DM, nullptr, KP(Wff2T), (float*)shm, w0);
          else { transpose_convert(KP(w_b_up), 512, DM, nullptr, KP(BupT), (float*)shm, w0);
                 transpose_convert(KP(w_a_up), 512, DM, nullptr, KP(AupT), (float*)shm, w0);
                 transpose_convert(KP(w_o), DM, DM, nullptr, KP(WoT), (float*)shm, w0);
                 transpose_convert(KP(w_ff1), DM, DFF, KP(norm2_g), KP(Wff1T), (float*)shm, w0); } }
    } else if (type == 2) {
        phase_e1(l);
    } else if (type == 3) {
        { pg8::Gemm g{KP(L), KP(LoraT), T_ALL, 1536, 256, 256, 256}; S.init(T_ALL, 1536, G, c);
          EpiLora E{KP(xb) + (size_t)T_ALL * 512, KP(sc_a), KP(sc_g)}; pg8::gemm_phase(lds, g, S, E); }
        { pg8::Gemm g{KP(xb), KP(PoolT), T_ALL, 512, 512, 512, 512}; S.init(T_ALL, 512, G, (c + 136) % G);
          EpiPool E{KP(z), KP(pool_scale) + (size_t)l * 512}; pg8::gemm_phase(lds, g, S, E); }
    } else if (type == 4) { phase_scan(l, shm); }
    else if (type == 5) {
        phase_e2(l, (68 * 4) % G);
        pg8::Gemm g{KP(z) + O_U, KP(BupT), T_ALL, DM, 512, DIN, 512}; S.init(T_ALL, DM, G, c);
        EpiGate<0> E{KP(z)}; pg8::gemm_phase(lds, g, S, E);
    } else if (type == 6) {
        unsigned* rdy = KP(bar) + XCD_BAR_WORDS + 1024 + (2 + l) * (68 * 64); float* out = KP(out);
        { pg8::Gemm g{KP(xb) + (size_t)T_ALL * 512, KP(AupT), T_P, DM, 512, 512, 512}; S.init(T_P, DM, G, c);
          EpiMergePub E{KP(z), rdy, 0, 0}; pg8::gemm_phase(lds, g, S, E); }
        { pg8::Gemm g{KP(xb) + (size_t)T_ALL * 512 + (size_t)T_P * 512, KP(AupT), T_ALL - T_P, DM, 512, 512, 512}; S.init(T_ALL - T_P, DM, G, c);
          EpiMergePub E{KP(z), rdy, T_P, 64}; pg8::gemm_phase(lds, g, S, E); }
        { pg8::Gemm g{KP(z), KP(WoT), T_P, DM, DM, DIN, DM}; S.init(T_P, DM, G, c);
          EpiRes E{l == 0 ? KP(x_prompt) : out, nullptr, out, KP(xb), KP(ssq)}; pg8::gemm_phase(lds, g, S, E, rdy, 32u, 64); }
        sample_splitk(lds, KP(z) + (size_t)T_P * DIN, DIN, KP(WoT), DM, l == 0 ? KP(x_sample) : out + (size_t)T_P * DM, out + (size_t)T_P * DM, KP(xb) + (size_t)T_P * DM, KP(ssq) + (size_t)T_P * 16,
                      (float*)KP(sc_a), KP(bar) + XCD_BAR_WORDS + (l * 2 + 0) * 256, G > 64 ? G - 64 : 0, rdy + 64 * 64, 32u, 4);
        if (l == 0) { if (G >= 256) transpose_convert(KP(w_ff2), DFF, DM, nullptr, KP(Wff2T), (float*)shm, 64, 128);
                      else transpose_convert(KP(w_ff2), DFF, DM, nullptr, KP(Wff2T), (float*)shm); }
        else { if (G >= 256) transpose_convert(KP(w_ff1) + (size_t)DM * DFF, DM, DFF, KP(norm2_g) + DM, KP(Wff1T), (float*)shm, 64, 128);
               else transpose_convert(KP(w_ff1) + (size_t)DM * DFF, DM, DFF, KP(norm2_g) + DM, KP(Wff1T), (float*)shm); }
    } else if (type == 8) {
        unsigned* rdy = KP(bar) + XCD_BAR_WORDS + 1024 + l * (68 * 64); float* out = KP(out);
        { pg8::Gemm g{KP(xb), KP(Wff1T), T_P, DFF, DM, DM, DM}; S.init(T_P, DFF, G, c);
          EpiFF1Pub E{KP(z), KP(ssq), rdy, 0, 0}; pg8::gemm_phase(lds, g, S, E); }
        { pg8::Gemm g{KP(xb) + (size_t)T_P * DM, KP(Wff1T), T_ALL - T_P, DFF, DM, DM, DM}; S.init(T_ALL - T_P, DFF, G, c);
          EpiFF1Pub E{KP(z), KP(ssq), rdy, T_P, 64}; pg8::gemm_phase(lds, g, S, E); }
        { pg8::Gemm g{KP(z), KP(Wff2T), T_P, DM, DFF, DFF, DFF}; S.init(T_P, DM, G, c);
          EpiRes E{out, nullptr, out, KP(xb), KP(ssq)}; pg8::gemm_phase(lds, g, S, E, rdy, 128u); }
        sample_splitk(lds, KP(z) + (size_t)T_P * DFF, DFF, KP(Wff2T), DFF, out + (size_t)T_P * DM, out + (size_t)T_P * DM, KP(xb) + (size_t)T_P * DM, KP(ssq) + (size_t)T_P * 16,
                      (float*)KP(sc_a), KP(bar) + XCD_BAR_WORDS + (l * 2 + 1) * 256, G > 64 ? G - 64 : 0, rdy + 64 * 64, 128u);
        if (l == 0 && G >= 256) {
            transpose_convert(KP(w_in) + (size_t)DM * DIN, DM, DIN, KP(norm1_g) + DM, KP(WinT), (float*)shm, 64, 128);
            transpose_convert(KP(w_b_up) + (size_t)512 * DM, 512, DM, nullptr, KP(BupT), (float*)shm, 64, 128);
            transpose_convert(KP(w_a_up) + (size_t)512 * DM, 512, DM, nullptr, KP(AupT), (float*)shm, 64, 128);
            transpose_convert(KP(w_o) + (size_t)DM * DM, DM, DM, nullptr, KP(WoT), (float*)shm, 64, 128);
            convert_lora_pool(1, 64, 128);
        } else if (l == 0) {
            transpose_convert(KP(w_in) + (size_t)DM * DIN, DM, DIN, KP(norm1_g) + DM, KP(WinT), (float*)shm);
            transpose_convert(KP(w_b_up) + (size_t)512 * DM, 512, DM, nullptr, KP(BupT), (float*)shm);
            transpose_convert(KP(w_a_up) + (size_t)512 * DM, 512, DM, nullptr, KP(AupT), (float*)shm);
            transpose_convert(KP(w_o) + (size_t)DM * DM, DM, DM, nullptr, KP(WoT), (float*)shm);
            convert_lora_pool(1);
        }
    } else { phase_final(); }
}

constexpr int NPHASE = 20;
__host__ __device__ __forceinline__ void phase_of(int i, int& type, int& l) {
    if (i == 0) { type = 0; l = 0; } else if (i == NPHASE - 1) { type = 10; l = 0; } else { l = (i - 1) / 9; type = 1 + (i - 1) % 9; }
}

__global__ __launch_bounds__(512, 2) void mega_kernel(Params P) {
    extern __shared__ __attribute__((aligned(16))) unsigned char shm[];
#if MULTI_LAUNCH
    run_phase(KI(phase_type), KI(phase_layer), shm);
#else
    cg::grid_group grid = cg::this_grid();
    volatile LAS unsigned* st = (volatile LAS unsigned*)((LAS unsigned char*)shm + 131072);
    if (threadIdx.x == 0) { st[0] = 0u; st[1] = 0u; }
    __syncthreads();
    const XcdBarrier xb = xcd_barrier_post(KP(bar), st);
    run_phase(0, 0, shm); xcd_barrier(xb);
    if (gridDim.y > 1u) grid.sync();
    run_phase(1, 0, shm); xcd_barrier(xb);
    run_phase(2, 0, shm); xcd_barrier(xb);
    run_phase(3, 0, shm); xcd_barrier(xb);
    run_phase(4, 0, shm); xcd_barrier(xb);
    run_phase(5, 0, shm); xcd_barrier(xb);
    run_phase(6, 0, shm); xcd_barrier(xb);
    run_phase(8, 0, shm); xcd_barrier(xb);
    run_phase(1, 1, shm); xcd_barrier(xb);
    run_phase(2, 1, shm); xcd_barrier(xb);
    run_phase(3, 1, shm); xcd_barrier(xb);
    run_phase(4, 1, shm); xcd_barrier(xb);
    run_phase(5, 1, shm); xcd_barrier(xb);
    run_phase(6, 1, shm); xcd_barrier(xb);
    run_phase(8, 1, shm); xcd_barrier(xb);
    run_phase(10, 0, shm);
#endif
}

extern "C" void kernel_launch(void* const* d_in, const int* in_sizes, int n_in, void* d_out, int out_size, void* d_ws, size_t ws_size, hipStream_t stream) {
    static int grid_blocks = 0;
    if (!grid_blocks) {
        int dev = 0, cus = 0, per_cu = 0;
        (void)hipGetDevice(&dev);
        (void)hipDeviceGetAttribute(&cus, hipDeviceAttributeMultiprocessorCount, dev);
        (void)hipFuncSetAttribute((const void*)mega_kernel, hipFuncAttributeMaxDynamicSharedMemorySize, LDS_BYTES);
        (void)hipOccupancyMaxActiveBlocksPerMultiprocessor(&per_cu, (const void*)mega_kernel, 512, LDS_BYTES);
        if (per_cu < 1) { fprintf(stderr, "occupancy query returned %d\n", per_cu); per_cu = 1; }
        grid_blocks = cus;
        if (grid_blocks > 256) grid_blocks = 256;
    }
    Params P{};
    const float* const* in = (const float* const*)d_in;
    P.x_prompt = in[0]; P.x_sample = in[1]; P.state_shift = in[2]; P.state_pool = in[3]; P.state_wkv = in[4];
    P.norm1_g = in[5]; P.w_in = in[6]; P.mu_shift = in[7]; P.decay0 = in[8]; P.w_decay2 = in[9]; P.a0 = in[10]; P.w_a2 = in[11]; P.w_g2 = in[12];
    P.k_k = in[13]; P.k_a = in[14]; P.r_k = in[15]; P.ln_x_g = in[16]; P.ln_x_b = in[17]; P.w_a_up = in[18]; P.w_pool = in[19]; P.pool_scale = in[20];
    P.w_b_up = in[21]; P.w_o = in[22]; P.norm2_g = in[23]; P.w_ff1 = in[24]; P.w_ff2 = in[25]; P.final_g = in[26];
    P.out = (float*)d_out;
    unsigned char* w = (unsigned char*)d_ws; size_t off = 0;
    auto take = [&](size_t bytes) { unsigned char* p = w + off; off += (bytes + 255) & ~(size_t)255; return p; };
    P.WinT = (bf16_t*)take((size_t)DIN * DM * 2); P.LoraT = (bf16_t*)take((size_t)1536 * 256 * 2); P.PoolT = (bf16_t*)take((size_t)512 * 512 * 2);
    P.BupT = (bf16_t*)take((size_t)DM * 512 * 2); P.AupT = (bf16_t*)take((size_t)DM * 512 * 2); P.WoT = (bf16_t*)take((size_t)DM * DM * 2);
    P.Wff1T = (bf16_t*)take((size_t)DFF * DM * 2); P.Wff2T = (bf16_t*)take((size_t)DM * DFF * 2);
    P.xb = (bf16_t*)take((size_t)T_ALL * DM * 2); P.ssq = (float*)take((size_t)T_ALL * 16 * 4); P.z = (bf16_t*)take((size_t)T_ALL * DIN * 2);
    P.L = (bf16_t*)take((size_t)T_ALL * 256 * 2); P.sc_a = (bf16_t*)take((size_t)T_ALL * 512 * 2); P.sc_g = (bf16_t*)take((size_t)T_ALL * 512 * 2);
    P.rk = (float*)take((size_t)T_ALL * 8 * 4);
    P.bar = (unsigned*)take((size_t)(XCD_BAR_WORDS + 1024 + 4 * 68 * 64) * 4);
    if (off > ws_size) { fprintf(stderr, "workspace too small: need %zu have %zu\n", off, ws_size); return; }
#if MULTI_LAUNCH
    for (int i = 0; i < NPHASE; ++i) {
        int type, l; phase_of(i, type, l);
        P.phase_type = type; P.phase_layer = l;
        hipLaunchKernelGGL(mega_kernel, dim3(grid_blocks), dim3(512), LDS_BYTES, stream, P);
    }
#else
    (void)hipMemsetAsync(P.bar, 0, (size_t)(XCD_BAR_WORDS + 1024 + 4 * 68 * 64) * 4, stream);
    void* args[] = {&P};
    hipError_t e = hipLaunchCooperativeKernel((const void*)mega_kernel, dim3(grid_blocks), dim3(512), args, LDS_BYTES, stream);
    if (e != hipSuccess) fprintf(stderr, "cooperative launch failed: %s (grid %d)\n", hipGetErrorString(e), grid_blocks);
#endif
}
```

```cpp
#include <hip/hip_runtime.h>
#include <hip/hip_cooperative_groups.h>
#include <cstdio>
#include <cstddef>
namespace cg = cooperative_groups;

#ifndef MULTI_LAUNCH
#define MULTI_LAUNCH 0
#endif

#define LAS __attribute__((address_space(3)))
typedef unsigned short bf16_t;
typedef short bf16x8 __attribute__((ext_vector_type(8)));
typedef float f32x4 __attribute__((ext_vector_type(4)));
typedef float f32x2 __attribute__((ext_vector_type(2)));
typedef unsigned u32x4 __attribute__((ext_vector_type(4)));
typedef unsigned u32x2 __attribute__((ext_vector_type(2)));

constexpr int T_ALL = 17408, T_P = 16384, SEQ = 2048, DSEQ = 8, NB = 8, NSB = 128;
constexpr int DM = 1024, DIN = 4352, DSH = 1792, DA = 512, DFF = 4096;
constexpr int O_LORA = 1536, O_U = 1792, O_GA = 2304, O_GB = 3328;
constexpr int LDS_BYTES = 131072 + 16;

constexpr size_t OUT_Y = 0;
constexpr size_t OUT_PSHIFT = 17825792;
constexpr size_t OUT_PPOOL = 17854464;
constexpr size_t OUT_PWKV = 17977344;
constexpr size_t OUT_SSHIFT = 18501632;
constexpr size_t OUT_SPOOL = 18960384;
constexpr size_t OUT_SWKV = 20926464;

struct Params {
    const float *x_prompt, *x_sample, *state_shift, *state_pool, *state_wkv;
    const float *norm1_g, *w_in, *mu_shift, *decay0, *w_decay2, *a0, *w_a2, *w_g2, *k_k, *k_a, *r_k, *ln_x_g, *ln_x_b;
    const float *w_a_up, *w_pool, *pool_scale, *w_b_up, *w_o, *norm2_g, *w_ff1, *w_ff2, *final_g;
    float* out;
    bf16_t *WinT, *LoraT, *PoolT, *BupT, *AupT, *WoT, *Wff1T, *Wff2T;
    bf16_t *xb;
    float* ssq;
    bf16_t* z;
    bf16_t* L;
    bf16_t* sc_a;
    bf16_t* sc_g;
    float* rk;
    unsigned* bar;
    int phase_type, phase_layer;
};

__device__ __forceinline__ float bf2f(bf16_t b) { return __uint_as_float(((unsigned)b) << 16); }
__device__ __forceinline__ float bflo(unsigned w) { return __uint_as_float(w << 16); }
__device__ __forceinline__ float bfhi(unsigned w) { return __uint_as_float(w & 0xffff0000u); }
__device__ __forceinline__ unsigned pk2(float lo, float hi) { unsigned r; asm volatile("v_cvt_pk_bf16_f32 %0, %1, %2" : "=v"(r) : "v"(lo), "v"(hi)); return r; }
__device__ __forceinline__ bf16_t f2bf(float f) { return (bf16_t)(pk2(f, 0.f) & 0xffffu); }
__device__ __forceinline__ float sigmoidf_(float x) { return 1.0f / (1.0f + __expf(-x)); }
__device__ __forceinline__ float tanhf_(float x) { return 1.0f - 2.0f / (__expf(2.0f * x) + 1.0f); }

template <int OFF> __device__ __forceinline__ void* karg_ptr() {
    unsigned long long r;
    asm volatile("s_load_dwordx2 %0, %1, %2\n\ts_waitcnt lgkmcnt(0)" : "=s"(r) : "s"(__builtin_amdgcn_kernarg_segment_ptr()), "n"(OFF) : "memory");
    return (void*)(__attribute__((address_space(1))) void*)r;
}
template <int OFF> __device__ __forceinline__ int karg_int() {
    int r;
    asm volatile("s_load_dword %0, %1, %2\n\ts_waitcnt lgkmcnt(0)" : "=s"(r) : "s"(__builtin_amdgcn_kernarg_segment_ptr()), "n"(OFF) : "memory");
    return r;
}
#define KP(f) ((decltype(Params::f))karg_ptr<(int)offsetof(Params, f)>())
#define KI(f) (karg_int<(int)offsetof(Params, f)>())

template <int CTRL> __device__ __forceinline__ float dpp_f(float x) {
    return __builtin_bit_cast(float, __builtin_amdgcn_update_dpp(0, __builtin_bit_cast(int, x), CTRL, 0xf, 0xf, false));
}
__device__ __forceinline__ float allsum16(float x) {
    x += dpp_f<0xB1>(x);
    x += dpp_f<0x4E>(x);
    x += dpp_f<0x141>(x);
    x += dpp_f<0x140>(x);
    return x;
}

namespace pg8 {
constexpr int BM = 256, BK = 64, HALF = 128, HTB = HALF * BK * 2, STAGE_BYTES = 8 * HTB, NXCD = 8, WGM = 8;
__host__ __device__ __forceinline__ int lds_byte(int r, int c) { const int st = (r >> 4) * 2 + (c >> 5), rr = r & 15, cc = c & 31, ob = rr * 64 + cc * 2; return st * 1024 + (ob ^ (((ob >> 9) & 1) << 5)); }
__host__ __device__ __forceinline__ void stage_rc(int b, int& R, int& C) { const int st = b / 1024, sb = b % 1024, swz = sb ^ (((sb >> 9) & 1) << 5); R = (st >> 1) * 16 + swz / 64; C = (st & 1) * 32 + (swz % 64) / 2; }
__host__ __device__ __forceinline__ int perm32(int rho) { const int n = rho >> 4, i = rho & 15; return 8 * (i >> 2) + 4 * n + (i & 3); }

struct Unit { int pm, pn; };
struct Gemm { const bf16_t* A; const bf16_t* Bt; int M, N, K, lda, ldb; };

struct StaticOrder {
    int nM, nN, nwg, G, c;
    __device__ void init(int M, int N, int G_, int c_) { nM = M / BM; nN = N / BM; nwg = nM * nN; G = G_; c = c_; }
    __device__ bool next(int i, Unit& u) const {
        const long L = (long)i * G + c; if (L >= nwg) return false;
        int wgid = (int)L; { const int q = nwg / NXCD, r = nwg % NXCD, xcd = wgid % NXCD, off = wgid / NXCD; wgid = (xcd < r ? xcd * (q + 1) : r * (q + 1) + (xcd - r) * q) + off; }
        const int nig = WGM * nN, gid = wgid / nig, fm = gid * WGM, gsz = (nM - fm) < WGM ? (nM - fm) : WGM;
        u.pm = fm + ((wgid % nig) % gsz); u.pn = (wgid % nig) / gsz; return true;
    }
};

template <class Epi>
__device__ __forceinline__ void gemm_phase(LAS unsigned char* lds, const Gemm g, const StaticOrder& S, const Epi& E, const unsigned* ready = nullptr, unsigned need = 0u, int npan = 0) {
    int tid_ = threadIdx.x; asm volatile("" : "+v"(tid_));
    const int tid = tid_, wid = __builtin_amdgcn_readfirstlane(tid >> 6), lane = tid & 63, wr = wid >> 2, wc = wid & 3, fr = lane & 15, fq = lane >> 4;
    const int K = g.K, nt = K / BK, lda = g.lda, ldb = g.ldb;
    unsigned voffA[2], voffB[2];
#pragma unroll
    for (int i = 0; i < 2; ++i) { int R, C; stage_rc(tid * 16 + i * 8192, R, C); const int Rb = Epi::PERM ? ((R & ~31) + perm32(R & 31)) : R;
        voffA[i] = (unsigned)(R * lda + C) * 2u; voffB[i] = (unsigned)(Rb * ldb + C) * 2u; }
    const size_t kstep = (size_t)(BK * 2);
    const size_t hA = (size_t)HALF * lda * 2, hB = (size_t)HALF * ldb * 2;
    const size_t tA = 2 * hA, tB = 2 * hB;
    const unsigned ldsw = (unsigned)wid * 1024u;
    const int aoff = lds_byte(wr * 64 + fr, fq * 8), boff = lds_byte(wc * 32 + fr, fq * 8);
#define PG8_SA(b, h) (((b) * 2 + (h)) * HTB)
#define PG8_SB(b, h) ((4 + (b) * 2 + (h)) * HTB)
#define PG8_STAGE(bufoff, gbase, voff) do { _Pragma("unroll") for (int _i = 0; _i < 2; ++_i) \
        __builtin_amdgcn_global_load_lds((const unsigned*)((const char*)(gbase) + (voff)[_i]), (LAS unsigned*)(lds + (bufoff) + ldsw + _i * 8192), 16, 0, 0); } while (0)
#define PG8_LDA(dst, b, h) do { _Pragma("unroll") for (int m = 0; m < 4; ++m) _Pragma("unroll") for (int k = 0; k < 2; ++k) dst[m][k] = *(const LAS bf16x8*)(lds + PG8_SA(b, h) + aoff + m * 2048 + k * 1024); } while (0)
#define PG8_LDB(dst, b, h) do { _Pragma("unroll") for (int n = 0; n < 2; ++n) _Pragma("unroll") for (int k = 0; k < 2; ++k) dst[n][k] = *(const LAS bf16x8*)(lds + PG8_SB(b, h) + boff + n * 2048 + k * 1024); } while (0)
#define PG8_MMA(ai, bj, At, Bt) do { __builtin_amdgcn_s_setprio(1); _Pragma("unroll") for (int m = 0; m < 4; ++m) _Pragma("unroll") for (int n = 0; n < 2; ++n) _Pragma("unroll") for (int k = 0; k < 2; ++k) \
        acc[ai][bj][m][n] = __builtin_amdgcn_mfma_f32_16x16x32_bf16(Bt[n][k], At[m][k], acc[ai][bj][m][n], 0, 0, 0); __builtin_amdgcn_s_setprio(0); } while (0)
#define PG8_WAIT_V(n) asm volatile("s_waitcnt vmcnt(" #n ")" ::: "memory")
#define PG8_WAIT_L(n) asm volatile("s_waitcnt lgkmcnt(" #n ")" ::: "memory")
#define PG8_BAR __builtin_amdgcn_s_barrier()
#define PG8_SCHED __builtin_amdgcn_sched_barrier(0)
    Unit cur, nxt; int ui = 0;
    if (!S.next(0, cur)) return;
#define PG8_A_READY(u_) do { if (ready) { if (tid < 64) { unsigned polls_ = 0; \
            if (npan > 0) { while (!__all(tid >= npan || __hip_atomic_load(ready + 64 * (tid < npan ? tid : 0), __ATOMIC_RELAXED, __HIP_MEMORY_SCOPE_AGENT) >= need)) { __builtin_amdgcn_s_sleep(2); if (++polls_ > (1u << 21)) break; } } \
            else while ((unsigned)__builtin_amdgcn_readfirstlane(__hip_atomic_load(ready + 64 * (u_).pm, __ATOMIC_RELAXED, __HIP_MEMORY_SCOPE_AGENT)) < need) { __builtin_amdgcn_s_sleep(2); if (++polls_ > (1u << 21)) break; } \
            __builtin_amdgcn_fence(__ATOMIC_ACQUIRE, "agent"); asm volatile("s_waitcnt vmcnt(0)" ::: "memory"); } \
        asm volatile("" ::: "memory"); __builtin_amdgcn_s_barrier(); asm volatile("" ::: "memory"); } } while (0)
    f32x4 acc[2][2][4][2];
#pragma unroll
    for (int a = 0; a < 2; ++a)
#pragma unroll
        for (int b = 0; b < 2; ++b)
#pragma unroll
            for (int m = 0; m < 4; ++m)
#pragma unroll
                for (int n = 0; n < 2; ++n) acc[a][b][m][n] = (f32x4){0.f, 0.f, 0.f, 0.f};
    bf16x8 At[4][2], B0[2][2], B1[2][2];
    const char* cA = (const char*)g.A + (size_t)cur.pm * tA; const char* cB = (const char*)g.Bt + (size_t)cur.pn * tB;
    PG8_A_READY(cur);
    PG8_STAGE(PG8_SB(0, 0), cB, voffB); PG8_STAGE(PG8_SA(0, 0), cA, voffA); PG8_STAGE(PG8_SB(0, 1), cB + hB, voffB); PG8_STAGE(PG8_SA(0, 1), cA + hA, voffA);
    if (wr == 1) PG8_BAR;
    PG8_WAIT_V(4); PG8_BAR;
    PG8_STAGE(PG8_SB(1, 0), cB + kstep, voffB); PG8_STAGE(PG8_SA(1, 0), cA + kstep, voffA); PG8_STAGE(PG8_SB(1, 1), cB + hB + kstep, voffB);
    PG8_WAIT_V(6); PG8_BAR;
    for (;;) {
        const bool has_next = S.next(ui + 1, nxt);
        const char* nA = has_next ? (const char*)g.A + (size_t)nxt.pm * tA : cA; const char* nB = has_next ? (const char*)g.Bt + (size_t)nxt.pn * tB : cB;
#pragma unroll 1
        for (int t = 0; t < nt; t += 2) {
            const bool last = (t == nt - 2);
            const char* a1 = cA + (size_t)(t + 1) * kstep;
            const char* a2 = last ? nA : cA + (size_t)(t + 2) * kstep; const char* b2 = last ? nB : cB + (size_t)(t + 2) * kstep;
            const char* a3 = a2 + kstep; const char* b3 = b2 + kstep;
            if (last && has_next) PG8_A_READY(nxt);
            PG8_LDB(B0, 0, 0); PG8_SCHED; PG8_LDA(At, 0, 0); PG8_STAGE(PG8_SA(1, 1), a1 + hA, voffA);
            PG8_WAIT_L(8); PG8_BAR; PG8_WAIT_L(0); PG8_MMA(0, 0, At, B0); PG8_BAR; PG8_SCHED;
            PG8_LDB(B1, 0, 1); PG8_STAGE(PG8_SB(0, 0), b2, voffB);
            PG8_BAR; PG8_WAIT_L(0); PG8_MMA(0, 1, At, B1); PG8_BAR;
            PG8_LDA(At, 0, 1); PG8_STAGE(PG8_SA(0, 0), a2, voffA);
            PG8_BAR; PG8_WAIT_L(0); PG8_MMA(1, 0, At, B0); PG8_BAR; PG8_SCHED;
            PG8_STAGE(PG8_SB(0, 1), b2 + hB, voffB);
            PG8_WAIT_V(6); PG8_BAR; PG8_MMA(1, 1, At, B1); PG8_BAR;
            PG8_LDB(B0, 1, 0); PG8_SCHED; PG8_LDA(At, 1, 0); PG8_STAGE(PG8_SA(0, 1), a2 + hA, voffA);
            PG8_WAIT_L(8); PG8_BAR; PG8_WAIT_L(0); PG8_MMA(0, 0, At, B0); PG8_BAR; PG8_SCHED;
            PG8_LDB(B1, 1, 1); PG8_STAGE(PG8_SB(1, 0), b3, voffB);
            PG8_BAR; PG8_WAIT_L(0); PG8_MMA(0, 1, At, B1); PG8_BAR;
            PG8_LDA(At, 1, 1); PG8_STAGE(PG8_SA(1, 0), a3, voffA);
            PG8_BAR; PG8_WAIT_L(0); PG8_MMA(1, 0, At, B0); PG8_BAR; PG8_SCHED;
            PG8_STAGE(PG8_SB(1, 1), b3 + hB, voffB);
            PG8_WAIT_V(6); PG8_BAR; PG8_MMA(1, 1, At, B1); PG8_BAR;
        }
        E(acc, cur, wr, wc, fr, fq);
        if (!has_next) break;
#pragma unroll
        for (int a = 0; a < 2; ++a)
#pragma unroll
            for (int b = 0; b < 2; ++b)
#pragma unroll
                for (int m = 0; m < 4; ++m)
#pragma unroll
                    for (int n = 0; n < 2; ++n) acc[a][b][m][n] = (f32x4){0.f, 0.f, 0.f, 0.f};
        cur = nxt; cA = nA; cB = nB; ++ui;
    }
    PG8_WAIT_V(0);
    if (wr == 0) PG8_BAR;
    PG8_BAR;
#undef PG8_A_READY
#undef PG8_SA
#undef PG8_SB
#undef PG8_STAGE
#undef PG8_LDA
#undef PG8_LDB
#undef PG8_MMA
#undef PG8_WAIT_V
#undef PG8_WAIT_L
#undef PG8_BAR
#undef PG8_SCHED
}
}
using pg8::Unit;

__device__ __forceinline__ float row_rstd(const float* ssq, int row) {
    const f32x4* p = (const f32x4*)(ssq + (size_t)row * 16);
    const f32x4 a = p[0], b = p[1], c = p[2], d = p[3];
    const float s = ((a[0] + a[1]) + (a[2] + a[3])) + ((b[0] + b[1]) + (b[2] + b[3])) + ((c[0] + c[1]) + (c[2] + c[3])) + ((d[0] + d[1]) + (d[2] + d[3]));
    return rsqrtf(s * (1.0f / 1024.0f) + 1e-6f);
}
__device__ __forceinline__ u32x4 pack8(const f32x4 v0, const f32x4 v1) { u32x4 w; w.x = pk2(v0[0], v0[1]); w.y = pk2(v0[2], v0[3]); w.z = pk2(v1[0], v1[1]); w.w = pk2(v1[2], v1[3]); return w; }
__device__ __forceinline__ void unpack8(const u32x4 w, f32x4& v0, f32x4& v1) { v0 = (f32x4){bflo(w.x), bfhi(w.x), bflo(w.y), bfhi(w.y)}; v1 = (f32x4){bflo(w.z), bfhi(w.z), bflo(w.w), bfhi(w.w)}; }

template <int ACT> struct EpiNormBf16 {
    static constexpr bool PERM = true;
    bf16_t* O; int ldc; const float* ssq;
    __device__ __forceinline__ void operator()(const f32x4 (&acc)[2][2][4][2], const Unit& u, int wr, int wc, int fr, int fq) const {
        const int row0 = u.pm * 256 + wr * 64 + fr, col0 = u.pn * 256 + wc * 32 + 8 * fq;
#pragma unroll
        for (int ai = 0; ai < 2; ++ai)
#pragma unroll
            for (int m = 0; m < 4; ++m) {
                const int row = row0 + ai * 128 + m * 16; const float rs = row_rstd(ssq, row);
                bf16_t* rowp = O + (size_t)row * ldc + col0;
#pragma unroll
                for (int bj = 0; bj < 2; ++bj) { f32x4 v0 = acc[ai][bj][m][0] * rs, v1 = acc[ai][bj][m][1] * rs;
                    if (ACT == 1) {
#pragma unroll
                        for (int j = 0; j < 4; ++j) { const float a = fmaxf(v0[j], 0.f), b = fmaxf(v1[j], 0.f); v0[j] = a * a; v1[j] = b * b; } }
                    *(u32x4*)(rowp + bj * 128) = pack8(v0, v1); }
            }
    }
};
struct EpiFF1Pub {
    static constexpr bool PERM = true;
    bf16_t* O; const float* ssq; unsigned* ready; int row_off, pm_off;
    __device__ __forceinline__ void operator()(const f32x4 (&acc)[2][2][4][2], const Unit& u, int wr, int wc, int fr, int fq) const {
        const __amdgpu_buffer_rsrc_t rsrc = __builtin_amdgcn_make_buffer_rsrc((void*)O, 0, T_ALL * DFF * 2, 0x00020000);
        const int row0 = row_off + u.pm * 256 + wr * 64 + fr, col0 = u.pn * 256 + wc * 32 + 8 * fq;
#pragma unroll
        for (int ai = 0; ai < 2; ++ai)
#pragma unroll
            for (int m = 0; m < 4; ++m) {
                const int row = row0 + ai * 128 + m * 16; const float rs = row_rstd(ssq, row);
#pragma unroll
                for (int bj = 0; bj < 2; ++bj) { f32x4 v0 = acc[ai][bj][m][0] * rs, v1 = acc[ai][bj][m][1] * rs;
#pragma unroll
                    for (int j = 0; j < 4; ++j) { const float a = fmaxf(v0[j], 0.f), b = fmaxf(v1[j], 0.f); v0[j] = a * a; v1[j] = b * b; }
                    __builtin_amdgcn_raw_buffer_store_b128(pack8(v0, v1), rsrc, (unsigned)(((size_t)row * DFF + col0 + bj * 128) * 2), 0, 16  ); }
            }
        asm volatile("s_waitcnt vmcnt(0)" ::: "memory");
        if (fr == 0 && fq == 0) (void)__hip_atomic_fetch_add(ready + 64 * (pm_off + u.pm), 1u, __ATOMIC_RELAXED, __HIP_MEMORY_SCOPE_AGENT);
    }
};
struct EpiLora {
    static constexpr bool PERM = true;
    bf16_t *sw, *sa, *sg;
    __device__ __forceinline__ void operator()(const f32x4 (&acc)[2][2][4][2], const Unit& u, int wr, int wc, int fr, int fq) const {
        const int sel = u.pn >> 1; const int row0 = u.pm * 256 + wr * 64 + fr, col0 = (u.pn & 1) * 256 + wc * 32 + 8 * fq;
        unsigned long long o_ = (unsigned long long)sw; if (sel == 1) o_ = (unsigned long long)sa; asm volatile("" : "+s"(o_)); if (sel == 2) o_ = (unsigned long long)sg; asm volatile("" : "+s"(o_));
        bf16_t* O = (bf16_t*)o_;
#pragma unroll
        for (int ai = 0; ai < 2; ++ai)
#pragma unroll
            for (int m = 0; m < 4; ++m) {
                bf16_t* rowp = O + (size_t)(row0 + ai * 128 + m * 16) * 512 + col0;
#pragma unroll
                for (int bj = 0; bj < 2; ++bj) *(u32x4*)(rowp + bj * 128) = pack8(acc[ai][bj][m][0], acc[ai][bj][m][1]);
            }
    }
};
struct EpiPool {
    static constexpr bool PERM = true;
    bf16_t* z; const float* scale;
    __device__ __forceinline__ void operator()(const f32x4 (&acc)[2][2][4][2], const Unit& u, int wr, int wc, int fr, int fq) const {
        const int row0 = u.pm * 256 + wr * 64 + fr, col0 = u.pn * 256 + wc * 32 + 8 * fq;
        f32x4 bv[2][2];
#pragma unroll
        for (int bj = 0; bj < 2; ++bj)
#pragma unroll
            for (int n = 0; n < 2; ++n) bv[bj][n] = *(const f32x4*)(scale + col0 + bj * 128 + 4 * n);
#pragma unroll
        for (int ai = 0; ai < 2; ++ai)
#pragma unroll
            for (int m = 0; m < 4; ++m) {
                bf16_t* rowp = z + (size_t)(row0 + ai * 128 + m * 16) * DIN + O_U + col0;
#pragma unroll
                for (int bj = 0; bj < 2; ++bj) *(u32x4*)(rowp + bj * 128) = pack8(acc[ai][bj][m][0] * bv[bj][0], acc[ai][bj][m][1] * bv[bj][1]);
            }
    }
};
template <int MODE> struct EpiGate {
    static constexpr bool PERM = true;
    bf16_t* z;
    __device__ __forceinline__ void operator()(const f32x4 (&acc)[2][2][4][2], const Unit& u, int wr, int wc, int fr, int fq) const {
        const int row0 = u.pm * 256 + wr * 64 + fr, col0 = u.pn * 256 + wc * 32 + 8 * fq;
#pragma unroll
        for (int ai = 0; ai < 2; ++ai)
#pragma unroll
            for (int m = 0; m < 4; ++m) {
                bf16_t* rowp = z + (size_t)(row0 + ai * 128 + m * 16) * DIN + col0;
#pragma unroll
                for (int bj = 0; bj < 2; ++bj) {
                    const u32x4 gw = *(const u32x4*)(rowp + (MODE == 0 ? O_GB : O_GA) + bj * 128);
                    f32x4 g0, g1; unpack8(gw, g0, g1);
                    f32x4 v0, v1;
#pragma unroll
                    for (int j = 0; j < 4; ++j) { v0[j] = sigmoidf_(g0[j]) * acc[ai][bj][m][0][j]; v1[j] = sigmoidf_(g1[j]) * acc[ai][bj][m][1][j]; }
                    if (MODE == 1) { const u32x4 mw = *(const u32x4*)(rowp + bj * 128); f32x4 m0, m1; unpack8(mw, m0, m1); v0 += m0; v1 += m1; }
                    *(u32x4*)(rowp + bj * 128) = pack8(v0, v1); }
            }
    }
};
struct EpiMergePub {
    static constexpr bool PERM = true;
    bf16_t* z; unsigned* ready; int row_off, pm_off;
    __device__ __forceinline__ void operator()(const f32x4 (&acc)[2][2][4][2], const Unit& u, int wr, int wc, int fr, int fq) const {
        const __amdgpu_buffer_rsrc_t rsrc = __builtin_amdgcn_make_buffer_rsrc((void*)z, 0, T_ALL * DIN * 2, 0x00020000);
        const int row0 = row_off + u.pm * 256 + wr * 64 + fr, col0 = u.pn * 256 + wc * 32 + 8 * fq;
#pragma unroll
        for (int ai = 0; ai < 2; ++ai)
#pragma unroll
            for (int m = 0; m < 4; ++m) {
                const int row = row0 + ai * 128 + m * 16;
                const bf16_t* rowp = z + (size_t)row * DIN + col0;
#pragma unroll
                for (int bj = 0; bj < 2; ++bj) {
                    const u32x4 gw = *(const u32x4*)(rowp + O_GA + bj * 128);
                    f32x4 g0, g1; unpack8(gw, g0, g1);
                    f32x4 v0, v1;
#pragma unroll
                    for (int j = 0; j < 4; ++j) { v0[j] = sigmoidf_(g0[j]) * acc[ai][bj][m][0][j]; v1[j] = sigmoidf_(g1[j]) * acc[ai][bj][m][1][j]; }
                    const u32x4 mw = *(const u32x4*)(rowp + bj * 128); f32x4 m0, m1; unpack8(mw, m0, m1); v0 += m0; v1 += m1;
                    __builtin_amdgcn_raw_buffer_store_b128(pack8(v0, v1), rsrc, (unsigned)(((size_t)row * DIN + col0 + bj * 128) * 2), 0, 16  ); }
            }
        asm volatile("s_waitcnt vmcnt(0)" ::: "memory");
        if (fr == 0 && fq == 0) (void)__hip_atomic_fetch_add(ready + 64 * (pm_off + u.pm), 1u, __ATOMIC_RELAXED, __HIP_MEMORY_SCOPE_AGENT);
    }
};
struct EpiRes {
    static constexpr bool PERM = false;
    const float* xoldA; const float* xoldB;
    float* xf; bf16_t* xb; float* ssq;
    __device__ __forceinline__ void operator()(const f32x4 (&acc)[2][2][4][2], const Unit& u, int wr, int wc, int fr, int fq) const {
        const int row0 = u.pm * 256 + wr * 64 + fr, col0 = u.pn * 256 + wc * 32 + 4 * fq;
        const float* xo = (u.pm < 64) ? xoldA : (xoldB - (size_t)T_P * DM);
#pragma unroll
        for (int ai = 0; ai < 2; ++ai)
#pragma unroll
            for (int m = 0; m < 4; ++m) {
                const int row = row0 + ai * 128 + m * 16; const size_t ro = (size_t)row * DM + col0;
                float s = 0.f;
#pragma unroll
                for (int bj = 0; bj < 2; ++bj)
#pragma unroll
                    for (int n = 0; n < 2; ++n) {
                        const size_t o = ro + bj * 128 + n * 16;
                        const f32x4 xn = *(const f32x4*)(xo + o) + acc[ai][bj][m][n];
                        *(f32x4*)(xf + o) = xn;
                        u32x2 w; w.x = pk2(xn[0], xn[1]); w.y = pk2(xn[2], xn[3]); *(u32x2*)(xb + o) = w;
                        s += (xn[0] * xn[0] + xn[1] * xn[1]) + (xn[2] * xn[2] + xn[3] * xn[3]);
                    }
                s += __shfl_xor(s, 16); s += __shfl_xor(s, 32);
                if (fq == 0) ssq[(size_t)row * 16 + u.pn * 4 + wc] = s;
            }
    }
};

#define RAW_BARRIER() do { asm volatile("s_waitcnt lgkmcnt(0)" ::: "memory"); __builtin_amdgcn_s_barrier(); asm volatile("" ::: "memory"); } while (0)
__device__ void transpose_convert(const float* src, int K, int N, const float* gain, bf16_t* dst, float* tile  , int wg0 = 0, int wgn = 0) {
    int tid_ = threadIdx.x; asm volatile("" : "+v"(tid_));
    const int tid = tid_, ntn = N / 64, ntiles = (K / 64) * ntn, nwg = wgn > 0 ? wgn : (int)gridDim.x - wg0;
    if ((int)blockIdx.x < wg0 || (int)blockIdx.x >= wg0 + nwg) return;
    const int r = tid >> 4, c4 = (tid & 15) * 4, n = tid >> 3, k8 = (tid & 7) * 8;
    int t = (int)blockIdx.x - wg0;
    f32x4 v0, v1; float g0 = 1.f, g1 = 1.f;
    if (t < ntiles) { const int k0 = (t / ntn) * 64, n0 = (t % ntn) * 64;
        v0 = *(const f32x4*)(src + (size_t)(k0 + r) * N + n0 + c4); v1 = *(const f32x4*)(src + (size_t)(k0 + r + 32) * N + n0 + c4);
        if (gain) { g0 = gain[k0 + r]; g1 = gain[k0 + r + 32]; } }
    for (; t < ntiles; t += nwg) {
        const int k0 = (t / ntn) * 64, n0 = (t % ntn) * 64;
        tile[r * 65 + c4 + 0] = v0[0] * g0; tile[r * 65 + c4 + 1] = v0[1] * g0; tile[r * 65 + c4 + 2] = v0[2] * g0; tile[r * 65 + c4 + 3] = v0[3] * g0;
        tile[(r + 32) * 65 + c4 + 0] = v1[0] * g1; tile[(r + 32) * 65 + c4 + 1] = v1[1] * g1; tile[(r + 32) * 65 + c4 + 2] = v1[2] * g1; tile[(r + 32) * 65 + c4 + 3] = v1[3] * g1;
        const int tn = t + nwg;
        if (tn < ntiles) { const int k1 = (tn / ntn) * 64, n1 = (tn % ntn) * 64;
            v0 = *(const f32x4*)(src + (size_t)(k1 + r) * N + n1 + c4); v1 = *(const f32x4*)(src + (size_t)(k1 + r + 32) * N + n1 + c4);
            if (gain) { g0 = gain[k1 + r]; g1 = gain[k1 + r + 32]; } }
        RAW_BARRIER();
        { u32x4 w;
          w.x = pk2(tile[(k8 + 0) * 65 + n], tile[(k8 + 1) * 65 + n]); w.y = pk2(tile[(k8 + 2) * 65 + n], tile[(k8 + 3) * 65 + n]);
          w.z = pk2(tile[(k8 + 4) * 65 + n], tile[(k8 + 5) * 65 + n]); w.w = pk2(tile[(k8 + 6) * 65 + n], tile[(k8 + 7) * 65 + n]);
          *(u32x4*)(dst + (size_t)(n0 + n) * K + k0 + k8) = w; }
        RAW_BARRIER();
    }
}
__device__ void convert_lora_pool(int l, int wg0 = 0, int wgn = 0) {
    const int nwg_ = wgn > 0 ? wgn : (int)gridDim.x - wg0;
    if ((int)blockIdx.x < wg0 || (int)blockIdx.x >= wg0 + nwg_) return;
    const int gtid = ((int)blockIdx.x - wg0) * 512 + threadIdx.x, nth = nwg_ * 512;
    { const float* wd = KP(w_decay2) + (size_t)l * 64 * 512; const float* wa = KP(w_a2) + (size_t)l * 64 * 512; const float* wg = KP(w_g2) + (size_t)l * 128 * 512;
      bf16_t* LoraT = KP(LoraT);
      for (int i = gtid; i < 1536 * 256; i += nth) { const int n = i >> 8, k = i & 255; float v = 0.f;
        if (n < 512) { if (k < 64) v = wd[k * 512 + n]; }
        else if (n < 1024) { if (k >= 64 && k < 128) v = wa[(k - 64) * 512 + (n - 512)]; }
        else { if (k >= 128) v = wg[(k - 128) * 512 + (n - 1024)]; }
        LoraT[i] = f2bf(v); } }
    { const float* wp = KP(w_pool) + (size_t)l * 4 * 128 * 128; bf16_t* PoolT = KP(PoolT);
      for (int i = gtid; i < 512 * 512; i += nth) { const int n = i >> 9, k = i & 511; const int g = n >> 7, d = n & 127; float v = 0.f;
        if ((k >> 7) == g) v = wp[(g * 128 + (k & 127)) * 128 + d];
        PoolT[i] = f2bf(v); } }
}
__device__ void convert_rest(int l, float* tile) {
    transpose_convert(KP(w_b_up) + (size_t)l * 512 * DM, 512, DM, nullptr, KP(BupT), tile);
    transpose_convert(KP(w_a_up) + (size_t)l * 512 * DM, 512, DM, nullptr, KP(AupT), tile);
    transpose_convert(KP(w_o) + (size_t)l * DM * DM, DM, DM, nullptr, KP(WoT), tile);
    transpose_convert(KP(w_ff1) + (size_t)l * DM * DFF, DM, DFF, KP(norm2_g) + (size_t)l * DM, KP(Wff1T), tile);
    transpose_convert(KP(w_ff2) + (size_t)l * DFF * DM, DFF, DM, nullptr, KP(Wff2T), tile);
}

__device__ void phase_prologue(float* tile) {
    transpose_convert(KP(w_in), DM, DIN, KP(norm1_g), KP(WinT), tile);
    convert_lora_pool(0);
    const float* x_prompt = KP(x_prompt); const float* x_sample = KP(x_sample); bf16_t* xb = KP(xb); float* ssq = KP(ssq);
    const int lane = threadIdx.x & 63, gw = blockIdx.x * 8 + (threadIdx.x >> 6), nw = gridDim.x * 8;
    for (int row = gw; row < T_ALL; row += nw) {
        const float* xr = row < T_P ? x_prompt + (size_t)row * DM : x_sample + (size_t)(row - T_P) * DM;
        float s = 0.f;
#pragma unroll
        for (int i = 0; i < 4; ++i) { const int c = i * 256 + lane * 4; const f32x4 v = *(const f32x4*)(xr + c);
            s += (v[0] * v[0] + v[1] * v[1]) + (v[2] * v[2] + v[3] * v[3]);
            u32x2 w; w.x = pk2(v[0], v[1]); w.y = pk2(v[2], v[3]); *(u32x2*)(xb + (size_t)row * DM + c) = w; }
#pragma unroll
        for (int o = 32; o >= 1; o >>= 1) s += __shfl_xor(s, o);
        if (lane < 16) ssq[(size_t)row * 16 + lane] = lane == 0 ? s : 0.f;
    }
}

struct Tok { int is_s, seq, t; };
__device__ __forceinline__ Tok tok_decode(int tok) { Tok r; if (tok < T_P) { r.is_s = 0; r.seq = tok >> 11; r.t = tok & 2047; } else { r.is_s = 1; r.seq = (tok - T_P) >> 3; r.t = (tok - T_P) & 7; } return r; }

__device__ void phase_e1(int l) {
    const int G_ = gridDim.x, bperm = (G_ % 8 == 0) ? (int)(blockIdx.x % 8) * (G_ / 8) + (int)(blockIdx.x / 8) : (int)blockIdx.x;
    const int gtid = bperm * 512 + threadIdx.x, nth = gridDim.x * 512;
    const bf16_t* z = KP(z); bf16_t* pbuf = KP(xb);
    bf16_t* Lb = KP(L);
    const float* mu = KP(mu_shift) + (size_t)l * DSH;
    const float* st_shift = KP(state_shift) + (size_t)l * NSB * DSH;
    const float* st_pool = KP(state_pool) + (size_t)l * NSB * 15 * 512;
    float* out = KP(out);
    for (int it = gtid; it < T_ALL * 32; it += nth) {
        const int tok = it >> 5, v = it & 31; const Tok tk = tok_decode(tok);
        const int c = O_LORA + v * 8; const bf16_t* zr = z + (size_t)tok * DIN + c;
        f32x4 x0, x1, p0, p1; unpack8(*(const u32x4*)zr, x0, x1);
        if (tk.t > 0) unpack8(*(const u32x4*)(zr - DIN), p0, p1);
        else if (tk.is_s) { const float* sp = st_shift + (size_t)tk.seq * DSH + c; p0 = *(const f32x4*)sp; p1 = *(const f32x4*)(sp + 4); }
        else { p0 = (f32x4){0.f, 0.f, 0.f, 0.f}; p1 = p0; }
        const f32x4 m0 = *(const f32x4*)(mu + c), m1 = *(const f32x4*)(mu + c + 4);
        x0 = x0 + (p0 - x0) * m0; x1 = x1 + (p1 - x1) * m1;
        if (v < 8) {
#pragma unroll
            for (int j = 0; j < 4; ++j) { x0[j] = tanhf_(x0[j]); x1[j] = tanhf_(x1[j]); } }
        else if (v >= 16) {
#pragma unroll
            for (int j = 0; j < 4; ++j) { x0[j] = sigmoidf_(x0[j]); x1[j] = sigmoidf_(x1[j]); } }
        *(u32x4*)(Lb + (size_t)tok * 256 + v * 8) = pack8(x0, x1);
    }
    for (int it = gtid; it < T_ALL * 64; it += nth) {
        const int gi = (it >> 6) & 3, tok = (it >> 8) * 4 + ((it >> 4) & 3), c = gi * 128 + (it & 15) * 8, win = 2 << gi; const Tok tk = tok_decode(tok);
        const bf16_t* zr = z + (size_t)tok * DIN + O_U + c;
        f32x4 u0, u1; unpack8(*(const u32x4*)zr, u0, u1);
        f32x4 s0 = u0, s1 = u1;
#define POOL_ROWS(W) { u32x4 rw[W - 1]; \
            _Pragma("unroll") for (int j = 1; j < W; ++j) rw[j - 1] = *(const u32x4*)(zr - (size_t)(tk.t - j >= 0 ? j : 0) * DIN); \
            _Pragma("unroll") for (int j = 1; j < W; ++j) { f32x4 a0, a1; unpack8(rw[j - 1], a0, a1); const float mk = (tk.t - j >= 0) ? 1.0f : 0.0f; s0 += a0 * mk; s1 += a1 * mk; } }
        if (gi == 0) POOL_ROWS(2) else if (gi == 1) POOL_ROWS(4) else if (gi == 2) POOL_ROWS(8) else POOL_ROWS(16)
#undef POOL_ROWS
        if (tk.is_s) {
            for (int j = tk.t + 1; j < win; ++j) { const float* sp = st_pool + ((size_t)tk.seq * 15 + (15 + tk.t - j)) * 512 + c; s0 += *(const f32x4*)sp; s1 += *(const f32x4*)(sp + 4); }
        }
        const int cnt = tk.is_s ? win : min(tk.t + 1, win);
        const float inv = 1.0f / (float)cnt;
        s0 = s0 * inv - u0; s1 = s1 * inv - u1;
        *(u32x4*)(pbuf + (size_t)tok * 512 + c) = pack8(s0, s1);
    }
    for (int i = gtid; i < (NB + NSB) * DSH; i += nth) {
        const int sq = i / DSH, c = i - sq * DSH;
        if (sq < NB) out[OUT_PSHIFT + ((size_t)l * NB + sq) * DSH + c] = bf2f(z[(size_t)(sq * SEQ + SEQ - 1) * DIN + c]);
        else { const int sb = sq - NB; out[OUT_SSHIFT + ((size_t)l * NSB + sb) * DSH + c] = bf2f(z[(size_t)(T_P + sb * DSEQ + DSEQ - 1) * DIN + c]); }
    }
    for (int i = gtid; i < (NB + NSB) * 15 * 512; i += nth) {
        const int sq = i / (15 * 512), r = (i / 512) % 15, c = i & 511;
        if (sq < NB) out[OUT_PPOOL + (((size_t)l * NB + sq) * 15 + r) * 512 + c] = bf2f(z[(size_t)(sq * SEQ + SEQ - 15 + r) * DIN + O_U + c]);
        else { const int sb = sq - NB; float v;
            if (r < 7) v = st_pool[((size_t)sb * 15 + (8 + r)) * 512 + c];
            else v = bf2f(z[(size_t)(T_P + sb * DSEQ + (r - 7)) * DIN + O_U + c]);
            out[OUT_SPOOL + (((size_t)l * NSB + sb) * 15 + r) * 512 + c] = v; }
    }
}

__device__ __forceinline__ f32x4 ld_bf4(const bf16_t* p) { const u32x2 w = *(const u32x2*)p; return (f32x4){bflo(w.x), bfhi(w.x), bflo(w.y), bfhi(w.y)}; }

__device__ void phase_e2(int l, int wg0) {
    if ((int)blockIdx.x < wg0) return;
    const int gtid = ((int)blockIdx.x - wg0) * 512 + threadIdx.x, nth = ((int)gridDim.x - wg0) * 512;
    const bf16_t* ybuf = KP(xb); bf16_t* ya = KP(xb) + (size_t)T_ALL * 512;
    const bf16_t* z = KP(z); const bf16_t* sc_g = KP(sc_g); const float* rkb = KP(rk);
    const float* mu = KP(mu_shift) + (size_t)l * DSH + 1024;
    const float* st_shift = KP(state_shift) + (size_t)l * NSB * DSH;
    const float* lng = KP(ln_x_g) + (size_t)l * 512; const float* lnb = KP(ln_x_b) + (size_t)l * 512;
    for (int it0 = gtid; it0 < T_ALL * 128; it0 += 2 * nth) {
        f32x4 y[2], v[2], vp[2], g[2], m4[2], lg[2], lb[2]; float rk[2]; int tokv[2], cv[2]; bool ok[2];
#pragma unroll
        for (int q = 0; q < 2; ++q) {
            const int it = it0 + q * nth; ok[q] = it < T_ALL * 128; const int itc = ok[q] ? it : it0;
            const int tok = itc >> 7, c = (itc & 127) * 4, h = c >> 6; const Tok tk = tok_decode(tok); tokv[q] = tok; cv[q] = c;
            y[q] = ld_bf4(ybuf + (size_t)tok * 512 + c);
            const bf16_t* zr = z + (size_t)tok * DIN + 1024 + c;
            v[q] = ld_bf4(zr);
            if (tk.t > 0) vp[q] = ld_bf4(zr - DIN);
            else if (tk.is_s) vp[q] = *(const f32x4*)(st_shift + (size_t)tk.seq * DSH + 1024 + c);
            else vp[q] = (f32x4){0.f, 0.f, 0.f, 0.f};
            m4[q] = *(const f32x4*)(mu + c); rk[q] = rkb[(size_t)tok * 8 + h];
            lg[q] = *(const f32x4*)(lng + c); lb[q] = *(const f32x4*)(lnb + c);
            g[q] = ld_bf4(sc_g + (size_t)tok * 512 + c);
        }
#pragma unroll
        for (int q = 0; q < 2; ++q) {
            f32x4 yy = y[q];
            const float mean = allsum16((yy[0] + yy[1]) + (yy[2] + yy[3])) * (1.0f / 64.0f);
            yy = yy - mean;
            const float var = allsum16((yy[0] * yy[0] + yy[1] * yy[1]) + (yy[2] * yy[2] + yy[3] * yy[3])) * (1.0f / 64.0f);
            const float rstd = rsqrtf(var + 64e-5f);
            const f32x4 vv = v[q] + (vp[q] - v[q]) * m4[q];
            const f32x4 o = ((yy * rstd) * lg[q] + lb[q] + vv * rk[q]) * g[q];
            u32x2 w; w.x = pk2(o[0], o[1]); w.y = pk2(o[2], o[3]);
            if (ok[q]) *(u32x2*)(ya + (size_t)tokv[q] * 512 + cv[q]) = w;
        }
    }
}

__device__ void phase_final() {
    float* out = KP(out); const float* ssq = KP(ssq); const float* fg = KP(final_g);
    const int lane = threadIdx.x & 63, gw = blockIdx.x * 8 + (threadIdx.x >> 6), nw = gridDim.x * 8;
    for (int row = gw; row < T_ALL; row += nw) {
        const float rs = row_rstd(ssq, row);
        float* xr = out + (size_t)row * DM;
#pragma unroll
        for (int i = 0; i < 4; ++i) { const int c = i * 256 + lane * 4; const f32x4 v = *(const f32x4*)(xr + c); const f32x4 g = *(const f32x4*)(fg + c);
            *(f32x4*)(xr + c) = v * rs * g; }
    }
}

constexpr int SC_TOKB = 1344;
constexpr int SC_CH = 32;
constexpr int SC_BUFB = SC_CH * SC_TOKB;
constexpr int NJOBS = 256 + 4096;
struct Job { int is_s, seq, h, rs, tok0, nsteps, first, last; };
__device__ __forceinline__ Job job_decode(int J, int ci) {
    Job j;
    if (J < 256) { const int pair = J >> 2; j.is_s = 0; j.seq = pair >> 3; j.h = pair & 7; j.rs = J & 3; j.tok0 = j.seq * SEQ + ci * SC_CH; j.nsteps = SC_CH; j.first = ci == 0; j.last = ci == SEQ / SC_CH - 1; }
    else { const int Js = J - 256, pair = Js >> 2; j.is_s = 1; j.seq = pair >> 3; j.h = pair & 7; j.rs = Js & 3; j.tok0 = T_P + j.seq * DSEQ; j.nsteps = 8; j.first = 1; j.last = 1; }
    return j;
}
struct ScanPtrs { const bf16_t *z, *sw, *sa; const float *st_shift, *mu, *k_k, *k_a, *r_k, *decay0, *a0; float* rk; };

struct LStage { u32x2 r, k, v, rp, kp, vp, sw, sa; f32x4 fr, fk, fv; };
__device__ __forceinline__ void scan_issue(const ScanPtrs& Q, int J, int ci, int ltid, LStage& L, int toff) {
    const Job jb = job_decode(J, ci);
    const int tt = (ltid >> 4) + toff, c = (ltid & 15) * 4;
    if (tt < jb.nsteps) {
        const int tok = jb.tok0 + tt; const int tseq = jb.is_s ? tt : ci * SC_CH + tt;
        const int gc = jb.h * 64 + c;
        const bf16_t* zr = Q.z + (size_t)tok * DIN + gc;
        L.r = *(const u32x2*)zr; L.k = *(const u32x2*)(zr + 512); L.v = *(const u32x2*)(zr + 1024);
        if (tseq > 0) { L.rp = *(const u32x2*)(zr - DIN); L.kp = *(const u32x2*)(zr - DIN + 512); L.vp = *(const u32x2*)(zr - DIN + 1024); }
        else if (jb.is_s) { const float* sp = Q.st_shift + (size_t)jb.seq * DSH + gc; L.fr = *(const f32x4*)sp; L.fk = *(const f32x4*)(sp + 512); L.fv = *(const f32x4*)(sp + 1024); }
        L.sw = *(const u32x2*)(Q.sw + (size_t)tok * 512 + gc); L.sa = *(const u32x2*)(Q.sa + (size_t)tok * 512 + gc);
    }
}
__device__ __forceinline__ f32x4 cv_bf4(const u32x2 w) { return (f32x4){bflo(w.x), bfhi(w.x), bflo(w.y), bfhi(w.y)}; }
__device__ __forceinline__ void scan_finish(const ScanPtrs& Q, int J, int ci, unsigned char* buf, int ltid, const LStage& L, int toff) {
    const Job jb = job_decode(J, ci);
    const int tt = (ltid >> 4) + toff, c = (ltid & 15) * 4;
    if (tt < jb.nsteps) {
        const int tok = jb.tok0 + tt; const int tseq = jb.is_s ? tt : ci * SC_CH + tt;
        const int gc = jb.h * 64 + c;
        f32x4 r = cv_bf4(L.r), k0 = cv_bf4(L.k), v = cv_bf4(L.v), rp, kp, vp;
        if (tseq > 0) { rp = cv_bf4(L.rp); kp = cv_bf4(L.kp); vp = cv_bf4(L.vp); }
        else if (jb.is_s) { rp = L.fr; kp = L.fk; vp = L.fv; }
        else { rp = (f32x4){0.f, 0.f, 0.f, 0.f}; kp = rp; vp = rp; }
        const float* mu = Q.mu + gc;
        r = r + (rp - r) * *(const f32x4*)mu; k0 = k0 + (kp - k0) * *(const f32x4*)(mu + 512); v = v + (vp - v) * *(const f32x4*)(mu + 1024);
        const f32x4 kk = k0 * *(const f32x4*)(Q.k_k + gc);
        const float ss = allsum16((kk[0] * kk[0] + kk[1] * kk[1]) + (kk[2] * kk[2] + kk[3] * kk[3]));
        const float inv = 1.0f / fmaxf(sqrtf(ss), 1e-12f);
        const f32x4 kkn = kk * inv;
        const f32x4 dw = cv_bf4(L.sw) + *(const f32x4*)(Q.decay0 + gc);
        const f32x4 da = cv_bf4(L.sa) + *(const f32x4*)(Q.a0 + gc);
        f32x4 dec, ain;
#pragma unroll
        for (int j = 0; j < 4; ++j) { dec[j] = __expf(-0.60653066f * sigmoidf_(dw[j])); ain[j] = sigmoidf_(da[j]); }
        const f32x4 ka = *(const f32x4*)(Q.k_a + gc);
        const f32x4 kf = k0 * (1.0f + (ain - 1.0f) * ka);
        const f32x4 rkw = *(const f32x4*)(Q.r_k + gc);
        const f32x4 pr = r * kf * rkw;
        const float rk = allsum16((pr[0] + pr[1]) + (pr[2] + pr[3]));
        unsigned char* tb = buf + tt * SC_TOKB + c * 4;
        *(f32x4*)(tb) = -kkn; *(f32x4*)(tb + 256) = dec; *(f32x4*)(tb + 512) = kkn * ain; *(f32x4*)(tb + 768) = kf; *(f32x4*)(tb + 1024) = r;
        if ((c >> 4) == jb.rs) *(f32x4*)(buf + tt * SC_TOKB + 1280 + (c & 15) * 4) = v;
        if (jb.rs == 0 && c == 0) Q.rk[(size_t)tok * 8 + jb.h] = rk;
    }
}
#define SC_BARRIER() do { asm volatile("s_waitcnt lgkmcnt(0)" ::: "memory"); __builtin_amdgcn_s_barrier(); asm volatile("" ::: "memory"); } while (0)
#define SC_ADV(J_, c_) do { if ((J_) < NJOBS) { if (++(c_) >= ((J_) < 256 ? SEQ / SC_CH : 1)) { (J_) += G; (c_) = 0; } } } while (0)

__device__ void phase_scan(int l, unsigned char* lds) {
    int tid_ = threadIdx.x; asm volatile("" : "+v"(tid_));
    const int tid = tid_, wid = tid >> 6, lane = tid & 63, G = gridDim.x;
    const bool loader = wid >= 4;
    if (!loader) __builtin_amdgcn_s_setprio(3);
    ScanPtrs Q;
    Q.z = KP(z); Q.sw = KP(xb) + (size_t)T_ALL * 512; Q.sa = KP(sc_a); Q.st_shift = KP(state_shift) + (size_t)l * NSB * DSH; Q.mu = KP(mu_shift) + (size_t)l * DSH;
    Q.k_k = KP(k_k) + (size_t)l * 512; Q.k_a = KP(k_a) + (size_t)l * 512; Q.r_k = KP(r_k) + (size_t)l * 512; Q.decay0 = KP(decay0) + (size_t)l * 512; Q.a0 = KP(a0) + (size_t)l * 512; Q.rk = KP(rk);
    bf16_t* ybuf = KP(xb);
    const float* st_wkv = KP(state_wkv); float* out = KP(out);
    int J = (G % 8 == 0) ? (int)(blockIdx.x % 8) * (G / 8) + (int)(blockIdx.x / 8) : (int)blockIdx.x, ci = 0, it = 0;
    int Ji = J, cis = 0;
    int Jg = J, cg_ = 0;
    LStage L, L2;
    f32x2 s01 = (f32x2){0.f, 0.f}, s23 = s01;
    f32x4 s_pref = (f32x4){0.f, 0.f, 0.f, 0.f};
    if (!loader && J >= 256 && J < NJOBS) { const Job j0 = job_decode(J, 0); s_pref = *(const f32x4*)(st_wkv + (((((size_t)l * NSB + j0.seq) * 8 + j0.h) * 64 + j0.rs * 16 + (wid * 4 + (lane >> 4))) * 64 + (lane & 15) * 4)); }
    if (loader) {
#pragma unroll 1
        for (int d = 0; d < 2; ++d) {
            if (Ji < NJOBS) { scan_issue(Q, Ji, cis, tid - 256, L, 0); scan_issue(Q, Ji, cis, tid - 256, L2, 16); scan_finish(Q, Ji, cis, lds + d * SC_BUFB, tid - 256, L, 0); scan_finish(Q, Ji, cis, lds + d * SC_BUFB, tid - 256, L2, 16); }
            SC_ADV(Ji, cis); SC_ADV(Jg, cg_);
        }
        if (Ji < NJOBS) { scan_issue(Q, Ji, cis, tid - 256, L, 0); scan_issue(Q, Ji, cis, tid - 256, L2, 16); }
        SC_ADV(Ji, cis);
    }
    SC_BARRIER();
    while (J < NJOBS) {
        int Jn = J, cn = ci; SC_ADV(Jn, cn);
        const unsigned char* buf = lds + (it % 3) * SC_BUFB;
        if (loader) {
            if (Jg < NJOBS) { scan_finish(Q, Jg, cg_, lds + ((it + 2) % 3) * SC_BUFB, tid - 256, L, 0); scan_finish(Q, Jg, cg_, lds + ((it + 2) % 3) * SC_BUFB, tid - 256, L2, 16); }
            SC_ADV(Jg, cg_);
            if (Ji < NJOBS) { scan_issue(Q, Ji, cis, tid - 256, L, 0); scan_issue(Q, Ji, cis, tid - 256, L2, 16); }
            SC_ADV(Ji, cis);
        } else {
            const Job jb = job_decode(J, ci);
            const int rl = wid * 4 + (lane >> 4), row = jb.rs * 16 + rl, c0 = (lane & 15) * 4;
            const size_t sidx = ((((size_t)l * (jb.is_s ? NSB : NB) + jb.seq) * 8 + jb.h) * 64 + row) * 64 + c0;
            if (jb.first) { s01 = (f32x2){0.f, 0.f}; s23 = s01;
                if (jb.is_s) { asm volatile("" ::: "memory");
                    s01 = (f32x2){s_pref[0], s_pref[1]}; s23 = (f32x2){s_pref[2], s_pref[3]}; } }
            if (Jn < NJOBS && Jn >= 256 && cn == 0 && Jn != J) { const Job jn = job_decode(Jn, 0);
                s_pref = *(const f32x4*)(st_wkv + (((((size_t)l * NSB + jn.seq) * 8 + jn.h) * 64 + jn.rs * 16 + rl) * 64 + c0)); }
            float yreg0 = 0.f, yreg1 = 0.f;
            for (int t8 = 0; t8 < (jb.nsteps < 16 ? jb.nsteps : 16); t8 += 4) {
#pragma unroll
                for (int u = 0; u < 4; ++u) {
                    const int tt = t8 + u;
                    const unsigned char* tb = buf + tt * SC_TOKB + c0 * 4;
                    const f32x4 a = *(const f32x4*)(tb), w = *(const f32x4*)(tb + 256), b = *(const f32x4*)(tb + 512), k = *(const f32x4*)(tb + 768), r = *(const f32x4*)(tb + 1024);
                    const float v = *(const float*)(buf + tt * SC_TOKB + 1280 + rl * 4);
                    const f32x2 a01 = (f32x2){a[0], a[1]}, a23 = (f32x2){a[2], a[3]}, w01 = (f32x2){w[0], w[1]}, w23 = (f32x2){w[2], w[3]}, b01 = (f32x2){b[0], b[1]}, b23 = (f32x2){b[2], b[3]};
                    const f32x2 k01 = (f32x2){k[0], k[1]}, k23 = (f32x2){k[2], k[3]}, r01 = (f32x2){r[0], r[1]}, r23 = (f32x2){r[2], r[3]};
                    const f32x2 pa = s01 * a01 + s23 * a23;
                    const float sa = allsum16(pa.x + pa.y);
                    const f32x2 kv01 = k01 * v, kv23 = k23 * v;
                    s01 = s01 * w01 + (b01 * sa + kv01); s23 = s23 * w23 + (b23 * sa + kv23);
                    const f32x2 py = s01 * r01 + s23 * r23;
                    const float y = allsum16(py.x + py.y);
                    if ((lane & 15) == (tt & 15)) yreg0 = y;
                }
            }
            for (int t8 = 16; t8 < (jb.nsteps < 32 ? jb.nsteps : 32); t8 += 4) {
#pragma unroll
                for (int u = 0; u < 4; ++u) {
                    const int tt = t8 + u;
                    const unsigned char* tb = buf + tt * SC_TOKB + c0 * 4;
                    const f32x4 a = *(const f32x4*)(tb), w = *(const f32x4*)(tb + 256), b = *(const f32x4*)(tb + 512), k = *(const f32x4*)(tb + 768), r = *(const f32x4*)(tb + 1024);
                    const float v = *(const float*)(buf + tt * SC_TOKB + 1280 + rl * 4);
                    const f32x2 a01 = (f32x2){a[0], a[1]}, a23 = (f32x2){a[2], a[3]}, w01 = (f32x2){w[0], w[1]}, w23 = (f32x2){w[2], w[3]}, b01 = (f32x2){b[0], b[1]}, b23 = (f32x2){b[2], b[3]};
                    const f32x2 k01 = (f32x2){k[0], k[1]}, k23 = (f32x2){k[2], k[3]}, r01 = (f32x2){r[0], r[1]}, r23 = (f32x2){r[2], r[3]};
                    const f32x2 pa = s01 * a01 + s23 * a23;
                    const float sa = allsum16(pa.x + pa.y);
                    const f32x2 kv01 = k01 * v, kv23 = k23 * v;
                    s01 = s01 * w01 + (b01 * sa + kv01); s23 = s23 * w23 + (b23 * sa + kv23);
                    const f32x2 py = s01 * r01 + s23 * r23;
                    const float y = allsum16(py.x + py.y);
                    if ((lane & 15) == (tt & 15)) yreg1 = y;
                }
            }
            if ((lane & 15) < jb.nsteps) ybuf[(size_t)(jb.tok0 + (lane & 15)) * 512 + jb.h * 64 + row] = f2bf(yreg0);
            if (16 + (lane & 15) < jb.nsteps) ybuf[(size_t)(jb.tok0 + 16 + (lane & 15)) * 512 + jb.h * 64 + row] = f2bf(yreg1);
            if (jb.last) *(f32x4*)(out + (jb.is_s ? OUT_SWKV : OUT_PWKV) + sidx) = (f32x4){s01.x, s01.y, s23.x, s23.y};
        }
        SC_BARRIER();
        J = Jn; ci = cn; ++it;
    }
    __builtin_amdgcn_s_setprio(0);
    __syncthreads();
}

#define XB_TMO      128
#define XB_XCNT(j)  (256  + 64 * (j))
#define XB_XSUB(j)  (1280 + 64 * (j))
#define XB_XGEN(j)  (2304 + 64 * (j))
#define XB_TOP      3328
#define XB_TOPGEN   3392
#define XCD_BAR_WORDS 3456
#define XB_SPIN_CAP (1u << 18)
__device__ __forceinline__ unsigned xb_ld(unsigned* p)              { return __hip_atomic_load(p, __ATOMIC_RELAXED, __HIP_MEMORY_SCOPE_AGENT); }
__device__ __forceinline__ unsigned xb_add(unsigned* p, unsigned v) { return __hip_atomic_fetch_add(p, v, __ATOMIC_RELAXED, __HIP_MEMORY_SCOPE_AGENT); }
__device__ __forceinline__ unsigned xb_xcc_id() { return (unsigned)__builtin_amdgcn_s_getreg((3 << 11) | 20) & 0xFu; }
#define XB_SPIN(cond, bar) do { unsigned _sp = 0; while (cond) { __builtin_amdgcn_s_sleep(1); \
    if ((++_sp & 255u) == 0u) { if (xb_ld(&(bar)[XB_TMO])) break; if (_sp > XB_SPIN_CAP) { atomicAdd(&(bar)[XB_TMO], 1u); break; } } } } while (0)
struct XcdBarrier { unsigned* bar; unsigned x; volatile LAS unsigned* st; };
__device__ __forceinline__ XcdBarrier xcd_barrier_post(unsigned* bar, volatile LAS unsigned* st) {
    XcdBarrier b; b.bar = bar; b.x = xb_xcc_id(); b.st = st;
    if (threadIdx.x == 0) (void)xb_add(&bar[XB_XCNT(b.x)], 1u);
    return b;
}
__device__ __forceinline__ void xcd_barrier_complete(unsigned* bar, unsigned x, unsigned& nloc, unsigned& nx) {
    const unsigned G = gridDim.x * gridDim.y * gridDim.z;
    unsigned sum, cnt, mine, sp = 0u;
    for (;;) {
        sum = 0u; cnt = 0u; mine = 0u;
#pragma unroll
        for (unsigned j = 0; j < 16; ++j) { const unsigned c = xb_ld(&bar[XB_XCNT(j)]); sum += c; cnt += (c > 0u) ? 1u : 0u; mine = (j == x) ? c : mine; }
        if (sum == G) break;
        __builtin_amdgcn_s_sleep(1);
        if ((++sp & 255u) == 0u) { if (xb_ld(&bar[XB_TMO])) break; if (sp > XB_SPIN_CAP) { atomicAdd(&bar[XB_TMO], 1u); break; } }
    }
    nloc = mine > 0u ? mine : 1u; nx = cnt > 0u ? cnt : 1u;
}
__device__ __forceinline__ void xcd_barrier(const XcdBarrier& b) {
    asm volatile("s_waitcnt vmcnt(0)" ::: "memory");
    __syncthreads();
    if (threadIdx.x == 0) {
        unsigned* bar = b.bar;
        __builtin_amdgcn_s_waitcnt(0);
        unsigned nloc = b.st[0], nx = b.st[1];
        if (nloc == 0u) { xcd_barrier_complete(bar, b.x, nloc, nx); b.st[0] = nloc; b.st[1] = nx; }
        const unsigned old = xb_add(&bar[XB_XSUB(b.x)], 1u);
        const unsigned gen = old / nloc;
        if (old + 1u == (gen + 1u) * nloc) {
            __builtin_amdgcn_fence(__ATOMIC_RELEASE, "agent");
            asm volatile("s_waitcnt vmcnt(0)" ::: "memory");
            const unsigned og = xb_add(&bar[XB_TOP], 1u);
            const unsigned tg = og / nx;
            if (og + 1u == (tg + 1u) * nx) xb_add(&bar[XB_TOPGEN], 1u);
            else XB_SPIN(xb_ld(&bar[XB_TOPGEN]) == tg, bar);
            __builtin_amdgcn_fence(__ATOMIC_ACQUIRE, "agent");
            xb_add(&bar[XB_XGEN(b.x)], 1u);
            asm volatile("s_waitcnt vmcnt(0)" ::: "memory");
        } else {
            XB_SPIN(xb_ld(&bar[XB_XGEN(b.x)]) == gen, bar);
            __builtin_amdgcn_fence(__ATOMIC_ACQUIRE, "agent");
            asm volatile("s_waitcnt vmcnt(0)" ::: "memory");
        }
    }
    __syncthreads();
}

struct EpiPartial {
    static constexpr bool PERM = false;
    float* part;
    __device__ __forceinline__ void operator()(const f32x4 (&acc)[2][2][4][2], const Unit& u, int wr, int wc, int fr, int fq) const {
        const int row0 = u.pm * 256 + wr * 64 + fr, col0 = u.pn * 256 + wc * 32 + 4 * fq;
#pragma unroll
        for (int ai = 0; ai < 2; ++ai)
#pragma unroll
            for (int m = 0; m < 4; ++m) { float* rowp = part + (size_t)(row0 + ai * 128 + m * 16) * DM + col0;
#pragma unroll
                for (int bj = 0; bj < 2; ++bj)
#pragma unroll
                    for (int n = 0; n < 2; ++n) *(f32x4*)(rowp + bj * 128 + n * 16) = acc[ai][bj][m][n]; }
    }
};
__device__ __forceinline__ void sample_splitk(LAS unsigned char* lds, const bf16_t* A, int lda, const bf16_t* Bt, int Ktot, const float* xold, float* xf_s, bf16_t* xb_s, float* ssq_s, float* part, unsigned* cnt, int cbase = 0, const unsigned* ready = nullptr, unsigned need = 0u, int npan = 0) {
    int G = gridDim.x, c = ((int)blockIdx.x - cbase + (int)gridDim.x) % (int)gridDim.x; asm volatile("" : "+s"(G), "+s"(c));
    const int Kq = Ktot >> 2;
    pg8::StaticOrder S;
#pragma unroll 1
    for (int kq = 0; kq < 4; ++kq) {
        pg8::Gemm g{A + (size_t)kq * Kq, Bt + (size_t)kq * Kq, 1024, DM, Kq, lda, Ktot};
        S.init(1024, DM, G, (c - 16 * kq + G) % G);
        EpiPartial E{part + (size_t)kq * 1024 * DM};
        pg8::gemm_phase(lds, g, S, E, ready, need, npan);
    }
    if (c < 64) {
        const int kq = c >> 4; Unit u; S.init(1024, DM, G, c & 15); S.next(0, u);
        unsigned* ctr = cnt + 64 * u.pm;
        asm volatile("s_waitcnt vmcnt(0)" ::: "memory");
        __syncthreads();
        if (threadIdx.x == 0) {
            __builtin_amdgcn_fence(__ATOMIC_RELEASE, "agent");
            asm volatile("s_waitcnt vmcnt(0)" ::: "memory");
            (void)__hip_atomic_fetch_add(ctr, 1u, __ATOMIC_RELAXED, __HIP_MEMORY_SCOPE_AGENT);
            unsigned sp = 0;
            while (__hip_atomic_load(ctr, __ATOMIC_RELAXED, __HIP_MEMORY_SCOPE_AGENT) < 16u) { __builtin_amdgcn_s_sleep(1); if (++sp > (1u << 22)) break; }
            __builtin_amdgcn_fence(__ATOMIC_ACQUIRE, "agent");
            asm volatile("s_waitcnt vmcnt(0)" ::: "memory");
        }
        __syncthreads();
        const int lane = threadIdx.x & 63, wv = threadIdx.x >> 6;
        const int rbase = u.pm * 256 + (kq * 4 + u.pn) * 16 + wv * 2;
#pragma unroll
        for (int rr = 0; rr < 2; ++rr) {
            const int row = rbase + rr; float sq = 0.f;
#pragma unroll
            for (int i = 0; i < 4; ++i) {
                const size_t o = (size_t)row * DM + i * 256 + lane * 4;
                f32x4 v = *(const f32x4*)(xold + o);
#pragma unroll
                for (int q = 0; q < 4; ++q) v += *(const f32x4*)(part + (size_t)q * 1024 * DM + o);
                *(f32x4*)(xf_s + o) = v;
                u32x2 w; w.x = pk2(v[0], v[1]); w.y = pk2(v[2], v[3]); *(u32x2*)(xb_s + o) = w;
                sq += (v[0] * v[0] + v[1] * v[1]) + (v[2] * v[2] + v[3] * v[3]);
            }
#pragma unroll
            for (int o = 32; o >= 1; o >>= 1) sq += __shfl_xor(sq, o);
            if (lane < 16) ssq_s[(size_t)row * 16 + lane] = lane == 0 ? sq : 0.f;
        }
    }
}

__device__ __forceinline__ void run_phase(int type, int l, unsigned char* shm) {
    LAS unsigned char* lds = (LAS unsigned char*)shm;
    pg8::StaticOrder S;
    int G = gridDim.x, c = blockIdx.x; asm volatile("" : "+s"(G), "+s"(c));
    if (type == 0) { phase_prologue((float*)shm); }
    else if (type == 1) {
        pg8::Gemm g{KP(xb), KP(WinT), T_ALL, DIN, DM, DM, DM}; S.init(T_ALL, DIN, G, c);
        EpiNormBf16<0> E{KP(z), DIN, KP(ssq)}; pg8::gemm_phase(lds, g, S, E);
        { const int w0 = (68 * 17) % G;
          if (l == 1) transpose_convert(KP(w_ff2) + (size_t)DFF * DM, DFF, DM, nullptr, KP(Wff2T), (float*)shm, w0);
          else { transpose_convert(KP(w_b_up), 512, DM, nullptr, KP(BupT), (float*)shm, w0);
                 transpose_convert(KP(w_a_up), 512, DM, nullptr, KP(AupT), (float*)shm, w0);
                 transpose_convert(KP(w_o), DM, DM, nullptr, KP(WoT), (float*)shm, w0);
                 transpose_convert(KP(w_ff1), DM, DFF, KP(norm2_g), KP(Wff1T), (float*)shm, w0); } }
    } else if (type == 2) {
        phase_e1(l);
    } else if (type == 3) {
        { pg8::Gemm g{KP(L), KP(LoraT), T_ALL, 1536, 256, 256, 256}; S.init(T_ALL, 1536, G, c);
          EpiLora E{KP(xb) + (size_t)T_ALL * 512, KP(sc_a), KP(sc_g)}; pg8::gemm_phase(lds, g, S, E); }
        { pg8::Gemm g{KP(xb), KP(PoolT), T_ALL, 512, 512, 512, 512}; S.init(T_ALL, 512, G, (c + 136) % G);
          EpiPool E{KP(z), KP(pool_scale) + (size_t)l * 512}; pg8::gemm_phase(lds, g, S, E); }
    } else if (type == 4) { phase_scan(l, shm); }
    else if (type == 5) {
        phase_e2(l, (68 * 4) % G);
        pg8::Gemm g{KP(z) + O_U, KP(BupT), T_ALL, DM, 512, DIN, 512}; S.init(T_ALL, DM, G, c);
        EpiGate<0> E{KP(z)}; pg8::gemm_phase(lds, g, S, E);
    } else if (type == 6) {
        unsigned* rdy = KP(bar) + XCD_BAR_WORDS + 1024 + (2 + l) * (68 * 64); float* out = KP(out);
        { pg8::Gemm g{KP(xb) + (size_t)T_ALL * 512, KP(AupT), T_P, DM, 512, 512, 512}; S.init(T_P, DM, G, c);
          EpiMergePub E{KP(z), rdy, 0, 0}; pg8::gemm_phase(lds, g, S, E); }
        { pg8::Gemm g{KP(xb) + (size_t)T_ALL * 512 + (size_t)T_P * 512, KP(AupT), T_ALL - T_P, DM, 512, 512, 512}; S.init(T_ALL - T_P, DM, G, c);
          EpiMergePub E{KP(z), rdy, T_P, 64}; pg8::gemm_phase(lds, g, S, E); }
        { pg8::Gemm g{KP(z), KP(WoT), T_P, DM, DM, DIN, DM}; S.init(T_P, DM, G, c);
          EpiRes E{l == 0 ? KP(x_prompt) : out, nullptr, out, KP(xb), KP(ssq)}; pg8::gemm_phase(lds, g, S, E, rdy, 32u, 64); }
        sample_splitk(lds, KP(z) + (size_t)T_P * DIN, DIN, KP(WoT), DM, l == 0 ? KP(x_sample) : out + (size_t)T_P * DM, out + (size_t)T_P * DM, KP(xb) + (size_t)T_P * DM, KP(ssq) + (size_t)T_P * 16,
                      (float*)KP(sc_a), KP(bar) + XCD_BAR_WORDS + (l * 2 + 0) * 256, G > 64 ? G - 64 : 0, rdy + 64 * 64, 32u, 4);
        if (l == 0) { if (G >= 256) transpose_convert(KP(w_ff2), DFF, DM, nullptr, KP(Wff2T), (float*)shm, 64, 128);
                      else transpose_convert(KP(w_ff2), DFF, DM, nullptr, KP(Wff2T), (float*)shm); }
        else { if (G >= 256) transpose_convert(KP(w_ff1) + (size_t)DM * DFF, DM, DFF, KP(norm2_g) + DM, KP(Wff1T), (float*)shm, 64, 128);
               else transpose_convert(KP(w_ff1) + (size_t)DM * DFF, DM, DFF, KP(norm2_g) + DM, KP(Wff1T), (float*)shm); }
    } else if (type == 8) {
        unsigned* rdy = KP(bar) + XCD_BAR_WORDS + 1024 + l * (68 * 64); float* out = KP(out);
        { pg8::Gemm g{KP(xb), KP(Wff1T), T_P, DFF, DM, DM, DM}; S.init(T_P, DFF, G, c);
          EpiFF1Pub E{KP(z), KP(ssq), rdy, 0, 0}; pg8::gemm_phase(lds, g, S, E); }
        { pg8::Gemm g{KP(xb) + (size_t)T_P * DM, KP(Wff1T), T_ALL - T_P, DFF, DM, DM, DM}; S.init(T_ALL - T_P, DFF, G, c);
          EpiFF1Pub E{KP(z), KP(ssq), rdy, T_P, 64}; pg8::gemm_phase(lds, g, S, E); }
        { pg8::Gemm g{KP(z), KP(Wff2T), T_P, DM, DFF, DFF, DFF}; S.init(T_P, DM, G, c);
          EpiRes E{out, nullptr, out, KP(xb), KP(ssq)}; pg8::gemm_phase(lds, g, S, E, rdy, 128u); }
        sample_splitk(lds, KP(z) + (size_t)T_P * DFF, DFF, KP(Wff2T), DFF, out + (size_t)T_P * DM, out + (size_t)T_P * DM, KP(xb) + (size_t)T_P * DM, KP(ssq) + (size_t)T_P * 16,
                      (float*)KP(sc_a), KP(bar) + XCD_BAR_WORDS + (l * 2 + 1) * 256, G > 64 ? G - 64 : 0, rdy + 64 * 64, 128u);
        if (l == 0 && G >= 256) {
            transpose_convert(KP(w_in) + (size_t)DM * DIN, DM, DIN, KP(norm1_g) + DM, KP(WinT), (float*)shm, 64, 128);
            transpose_convert(KP(w_b_up) + (size_t)512 * DM, 512, DM, nullptr, KP(BupT), (float*)shm, 64, 128);
            transpose_convert(KP(w_a_up) + (size_t)512 * DM, 512, DM, nullptr, KP(AupT), (float*)shm, 64, 128);
            transpose_convert(KP(w_o) + (size_t)DM * DM, DM, DM, nullptr, KP(WoT), (float*)shm, 64, 128);
            convert_lora_pool(1, 64, 128);
        } else if (l == 0) {
            transpose_convert(KP(w_in) + (size_t)DM * DIN, DM, DIN, KP(norm1_g) + DM, KP(WinT), (float*)shm);
            transpose_convert(KP(w_b_up) + (size_t)512 * DM, 512, DM, nullptr, KP(BupT), (float*)shm);
            transpose_convert(KP(w_a_up) + (size_t)512 * DM, 512, DM, nullptr, KP(AupT), (float*)shm);
            transpose_convert(KP(w_o) + (size_t)DM * DM, DM, DM, nullptr, KP(WoT), (float*)shm);
            convert_lora_pool(1);
        }
    } else { phase_final(); }
}

constexpr int NPHASE = 20;
__host__ __device__ __forceinline__ void phase_of(int i, int& type, int& l) {
    if (i == 0) { type = 0; l = 0; } else if (i == NPHASE - 1) { type = 10; l = 0; } else { l = (i - 1) / 9; type = 1 + (i - 1) % 9; }
}

__global__ __launch_bounds__(512, 2) void mega_kernel(Params P) {
    extern __shared__ __attribute__((aligned(16))) unsigned char shm[];
#if MULTI_LAUNCH
    run_phase(KI(phase_type), KI(phase_layer), shm);
#else
    cg::grid_group grid = cg::this_grid();
    volatile LAS unsigned* st = (volatile LAS unsigned*)((LAS unsigned char*)shm + 131072);
    if (threadIdx.x == 0) { st[0] = 0u; st[1] = 0u; }
    __syncthreads();
    const XcdBarrier xb = xcd_barrier_post(KP(bar), st);
    run_phase(0, 0, shm); xcd_barrier(xb);
    if (gridDim.y > 1u) grid.sync();
    run_phase(1, 0, shm); xcd_barrier(xb);
    run_phase(2, 0, shm); xcd_barrier(xb);
    run_phase(3, 0, shm); xcd_barrier(xb);
    run_phase(4, 0, shm); xcd_barrier(xb);
    run_phase(5, 0, shm); xcd_barrier(xb);
    run_phase(6, 0, shm); xcd_barrier(xb);
    run_phase(8, 0, shm); xcd_barrier(xb);
    run_phase(1, 1, shm); xcd_barrier(xb);
    run_phase(2, 1, shm); xcd_barrier(xb);
    run_phase(3, 1, shm); xcd_barrier(xb);
    run_phase(4, 1, shm); xcd_barrier(xb);
    run_phase(5, 1, shm); xcd_barrier(xb);
    run_phase(6, 1, shm); xcd_barrier(xb);
    run_phase(8, 1, shm); xcd_barrier(xb);
    run_phase(10, 0, shm);
#endif
}

extern "C" void kernel_launch(void* const* d_in, const int* in_sizes, int n_in, void* d_out, int out_size, void* d_ws, size_t ws_size, hipStream_t stream) {
    static int grid_blocks = 0;
    if (!grid_blocks) {
        int dev = 0, cus = 0, per_cu = 0;
        (void)hipGetDevice(&dev);
        (void)hipDeviceGetAttribute(&cus, hipDeviceAttributeMultiprocessorCount, dev);
        (void)hipFuncSetAttribute((const void*)mega_kernel, hipFuncAttributeMaxDynamicSharedMemorySize, LDS_BYTES);
        (void)hipOccupancyMaxActiveBlocksPerMultiprocessor(&per_cu, (const void*)mega_kernel, 512, LDS_BYTES);
        if (per_cu < 1) { fprintf(stderr, "occupancy query returned %d\n", per_cu); per_cu = 1; }
        grid_blocks = cus;
        if (grid_blocks > 256) grid_blocks = 256;
    }
    Params P{};
    const float* const* in = (const float* const*)d_in;
    P.x_prompt = in[0]; P.x_sample = in[1]; P.state_shift = in[2]; P.state_pool = in[3]; P.state_wkv = in[4];
    P.norm1_g = in[5]; P.w_in = in[6]; P.mu_shift = in[7]; P.decay0 = in[8]; P.w_decay2 = in[9]; P.a0 = in[10]; P.w_a2 = in[11]; P.w_g2 = in[12];
    P.k_k = in[13]; P.k_a = in[14]; P.r_k = in[15]; P.ln_x_g = in[16]; P.ln_x_b = in[17]; P.w_a_up = in[18]; P.w_pool = in[19]; P.pool_scale = in[20];
    P.w_b_up = in[21]; P.w_o = in[22]; P.norm2_g = in[23]; P.w_ff1 = in[24]; P.w_ff2 = in[25]; P.final_g = in[26];
    P.out = (float*)d_out;
    unsigned char* w = (unsigned char*)d_ws; size_t off = 0;
    auto take = [&](size_t bytes) { unsigned char* p = w + off; off += (bytes + 255) & ~(size_t)255; return p; };
    P.WinT = (bf16_t*)take((size_t)DIN * DM * 2); P.LoraT = (bf16_t*)take((size_t)1536 * 256 * 2); P.PoolT = (bf16_t*)take((size_t)512 * 512 * 2);
    P.BupT = (bf16_t*)take((size_t)DM * 512 * 2); P.AupT = (bf16_t*)take((size_t)DM * 512 * 2); P.WoT = (bf16_t*)take((size_t)DM * DM * 2);
    P.Wff1T = (bf16_t*)take((size_t)DFF * DM * 2); P.Wff2T = (bf16_t*)take((size_t)DM * DFF * 2);
    P.xb = (bf16_t*)take((size_t)T_ALL * DM * 2); P.ssq = (float*)take((size_t)T_ALL * 16 * 4); P.z = (bf16_t*)take((size_t)T_ALL * DIN * 2);
    P.L = (bf16_t*)take((size_t)T_ALL * 256 * 2); P.sc_a = (bf16_t*)take((size_t)T_ALL * 512 * 2); P.sc_g = (bf16_t*)take((size_t)T_ALL * 512 * 2);
    P.rk = (float*)take((size_t)T_ALL * 8 * 4);
    P.bar = (unsigned*)take((size_t)(XCD_BAR_WORDS + 1024 + 4 * 68 * 64) * 4);
    if (off > ws_size) { fprintf(stderr, "workspace too small: need %zu have %zu\n", off, ws_size); return; }
#if MULTI_LAUNCH
    for (int i = 0; i < NPHASE; ++i) {
        int type, l; phase_of(i, type, l);
        P.phase_type = type; P.phase_layer = l;
        hipLaunchKernelGGL(mega_kernel, dim3(grid_blocks), dim3(512), LDS_BYTES, stream, P);
    }
#else
    (void)hipMemsetAsync(P.bar, 0, (size_t)(XCD_BAR_WORDS + 1024 + 4 * 68 * 64) * 4, stream);
    void* args[] = {&P};
    hipError_t e = hipLaunchCooperativeKernel((const void*)mega_kernel, dim3(grid_blocks), dim3(512), args, LDS_BYTES, stream);
    if (e != hipSuccess) fprintf(stderr, "cooperative launch failed: %s (grid %d)\n", hipGetErrorString(e), grid_blocks);
#endif
}
```
